# Optimizing an MI355X kernel written in HIP

```python
import jax, jax.numpy as jnp
from jax import lax
import numpy as np

D_MODEL = 1024
BATCH = 16
SEQ = 2048
DEPTH = 4

HEAD_DIM = 64
N_HEADS_MIX = 8
W_MIX = N_HEADS_MIX * HEAD_DIM
N_BRANCH = 3
DILATED_PAIRS = ((128, 1), (512, 4), (2048, 16))
QBLK = 128
ROT_DIM = HEAD_DIM // 4
ROPE_THETA = 500000.0
GRID_W = 64
NA_WIN_ROWS = 8
NA_WIN_COLS = 16
DECAY_LORA = 64
ICLR_LORA = 64
GATE_LORA = 128
DECAY_SCALE = 0.6065306597126334
D_FF = ((8 * D_MODEL // 3 + 255) // 256) * 256
N_MOD = 9
RMS_EPS = 1e-6
GN_EPS = 64e-5
NEG = -1e30
IN_SPLITS = (W_MIX, W_MIX, W_MIX,
             W_MIX, W_MIX, W_MIX,
             W_MIX, W_MIX, W_MIX,
             DECAY_LORA, DECAY_LORA,
             ICLR_LORA, ICLR_LORA,
             GATE_LORA,
             D_MODEL, D_MODEL, D_MODEL)
D_IN = sum(IN_SPLITS)

kernel_name = "hybrid_dilated_natten_rwkv7_encoder"


def rmsnorm(x, g):
    xf = x.astype(jnp.float32)
    y = xf * lax.rsqrt(jnp.mean(xf * xf, axis=-1, keepdims=True) + RMS_EPS)
    return (y * g.astype(jnp.float32)).astype(x.dtype)


def modulate(h, shift, scale):
    return h * (1 + scale[:, None, :]) + shift[:, None, :]


def swiglu(h, wi, wo):
    gate, up = jnp.split(h @ wi, 2, axis=-1)
    return (jax.nn.silu(gate) * up) @ wo


def partial_rotary(t, positions):
    half = ROT_DIM // 2
    inv_freq = ROPE_THETA ** (-jnp.arange(half, dtype=jnp.float32) * 2.0 / ROT_DIM)
    ang = positions.astype(jnp.float32)[..., None] * inv_freq
    cos, sin = jnp.cos(ang)[:, :, None, :], jnp.sin(ang)[:, :, None, :]
    tr = t[..., :ROT_DIM].astype(jnp.float32)
    t1, t2 = tr[..., :half], tr[..., half:]
    rot = jnp.concatenate([t1 * cos - t2 * sin, t2 * cos + t1 * sin], axis=-1)
    return jnp.concatenate([rot.astype(t.dtype), t[..., ROT_DIM:]], axis=-1)


def banded_attention(q, k, v, radius):
    lead = q.shape[:-2]
    L, hd = q.shape[-2], q.shape[-1]
    nb = -(-L // QBLK)
    lp = nb * QBLK
    kw = QBLK + 2 * radius
    pad = [(0, 0)] * len(lead)
    qb = jnp.pad(q, pad + [(0, lp - L), (0, 0)]).reshape(*lead, nb, QBLK, hd)
    kp = jnp.pad(k, pad + [(radius, radius + lp - L), (0, 0)])
    vp = jnp.pad(v, pad + [(radius, radius + lp - L), (0, 0)])
    idx = np.arange(nb)[:, None] * QBLK + np.arange(kw)[None, :]
    kb = kp[..., idx, :]
    vb = vp[..., idx, :]
    s = jnp.einsum("...nqd,...nkd->...nqk", qb, kb).astype(jnp.float32) * (hd ** -0.5)
    key_pos = idx - radius
    q_pos = np.arange(nb)[:, None] * QBLK + np.arange(QBLK)[None, :]
    off = key_pos[:, None, :] - q_pos[:, :, None]
    valid = (np.abs(off) <= radius) & (key_pos[:, None, :] >= 0) & (key_pos[:, None, :] < L)
    s = jnp.where(valid, s, NEG)
    m = jnp.max(s, axis=-1, keepdims=True)
    p = jnp.exp(s - m)
    den = jnp.sum(p, axis=-1, keepdims=True)
    o = jnp.einsum("...nqk,...nkd->...nqd", (p / den).astype(v.dtype), vb)
    lse = (m + jnp.log(den))[..., 0]
    return o.reshape(*lead, lp, hd)[..., :L, :], lse.reshape(*lead, lp)[..., :L]


def dilated_attention(q, k, v):
    B, S, H, hd = q.shape
    q, k, v = (t.transpose(0, 2, 1, 3) for t in (q, k, v))
    outs, lses = [], []
    for window, dil in DILATED_PAIRS:
        radius = window // (2 * dil)
        to_cls = lambda t: t.reshape(B, H, S // dil, dil, hd).swapaxes(2, 3)
        o, lse = banded_attention(to_cls(q), to_cls(k), to_cls(v), radius)
        outs.append(o.swapaxes(2, 3).reshape(B, H, S, hd))
        lses.append(lse.swapaxes(2, 3).reshape(B, H, S))
    alpha = jax.nn.softmax(jnp.stack(lses), axis=0)
    o = jnp.einsum("gbhs,gbhsd->bhsd", alpha, jnp.stack(outs).astype(jnp.float32))
    return o.astype(v.dtype).transpose(0, 2, 1, 3).reshape(B, S, H * hd)


def neighborhood_attention(q, k, v, rpb):
    B, S, H, hd = q.shape
    rows = S // GRID_W
    wr = min(NA_WIN_ROWS, rows)
    wc = NA_WIN_COLS
    grid = lambda t: t.reshape(B, rows, GRID_W, H, hd).transpose(0, 3, 1, 2, 4)
    qg, kg, vg = grid(q), grid(k), grid(v)
    r_start = np.clip(np.arange(rows) - wr // 2, 0, rows - wr)
    row_idx = r_start[:, None] + np.arange(wr)[None, :]
    kr = kg[:, :, row_idx]
    vr = vg[:, :, row_idx]
    s = jnp.einsum("bhrqd,bhrikd->bhrqik", qg, kr).astype(jnp.float32) * (hd ** -0.5)
    cols = np.arange(GRID_W)
    c_start = np.clip(cols - wc // 2, 0, GRID_W - wc)
    col_in = (cols[None, :] >= c_start[:, None]) & (cols[None, :] < c_start[:, None] + wc)
    roff = row_idx - np.arange(rows)[:, None] + NA_WIN_ROWS - 1
    coff = np.clip(cols[None, :] - cols[:, None], -(wc - 1), wc - 1) + wc - 1
    bias = rpb[:, roff[:, None, :, None], coff[None, :, None, :]]
    s = jnp.where(col_in[:, None, :], s + bias[None].astype(jnp.float32), NEG)
    shp = s.shape
    p = jax.nn.softmax(s.reshape(*shp[:-2], shp[-2] * shp[-1]), axis=-1).reshape(shp)
    o = jnp.einsum("bhrqik,bhrikd->bhrqd", p.astype(v.dtype), vr)
    return o.transpose(0, 2, 3, 1, 4).reshape(B, S, H * hd)


def _neighbour_pair(tf, tb):
    prev = jnp.pad(tf, ((0, 0), (1, 0), (0, 0)))[:, :-1]
    nxt = jnp.pad(tb, ((0, 0), (0, 1), (0, 0)))[:, 1:]
    return jnp.stack([prev, nxt])


def _token_shift(tf, tb, mu):
    base = jnp.stack([tf, tb])
    return base + (_neighbour_pair(tf, tb) - base) * mu[:, None, None, :]


def _flip_bwd(t):
    return jnp.stack([t[0], jnp.flip(t[1], axis=1)])


def _rwkv_step(state, inp):
    r, w, k, v, a_vec, b_vec = inp
    sa = jnp.einsum("dbhvk,dbhk->dbhv", state, a_vec)
    state = state * w[..., None, :] + sa[..., None] * b_vec[..., None, :] + v[..., None] * k[..., None, :]
    y = jnp.einsum("dbhvk,dbhk->dbhv", state, r)
    return state, y


def rwkv7_bidirectional(pr, pk, pv, pwf, pwb, paf, pab, pg, mu_rkv, mu_w, mu_a,
                        w0, w_up, a0, a_up, g_up, k_k, k_a, r_k, gn_w, gn_b):
    B, S, C = pr.shape
    H, N = N_HEADS_MIX, HEAD_DIM
    f32 = jnp.float32
    r = _token_shift(pr, pr, mu_rkv[:, 0])
    k = _token_shift(pk, pk, mu_rkv[:, 1])
    v = _token_shift(pv, pv, mu_rkv[:, 2])
    xw = _token_shift(pwf, pwb, mu_w)
    xa = _token_shift(paf, pab, mu_a)
    wz = w0[:, None, None, :] + jnp.einsum("dbsr,drc->dbsc", jnp.tanh(xw), w_up)
    decay = jnp.exp(-DECAY_SCALE * jax.nn.sigmoid(wz.astype(f32)))
    a = jax.nn.sigmoid((a0[:, None, None, :] + jnp.einsum("dbsr,drc->dbsc", xa, a_up)).astype(f32))
    hs = lambda t: t.reshape(2, B, S, H, N).astype(f32)
    r, k, v, decay, a = hs(r), hs(k), hs(v), hs(decay), hs(a)
    kk = k * k_k.reshape(H, N).astype(f32)
    kk = kk / jnp.maximum(jnp.sqrt(jnp.sum(kk * kk, axis=-1, keepdims=True)), 1e-12)
    k = k * (1 + (a - 1) * k_a.reshape(H, N).astype(f32))
    tm = lambda t: jnp.moveaxis(_flip_bwd(t), 2, 0)
    init = jnp.zeros((2, B, H, N, N), f32)
    _, ys = lax.scan(_rwkv_step, init, (tm(r), tm(decay), tm(k), tm(v), tm(-kk), tm(kk * a)))
    y = _flip_bwd(jnp.moveaxis(ys, 0, 2))
    mean = jnp.mean(y, axis=-1, keepdims=True)
    var = jnp.mean(jnp.square(y - mean), axis=-1, keepdims=True)
    yn = ((y - mean) * lax.rsqrt(var + GN_EPS)).reshape(2, B, S, C) * gn_w.astype(f32) + gn_b.astype(f32)
    bonus = (jnp.sum(r * k * r_k.astype(f32), axis=-1, keepdims=True) * v).reshape(2, B, S, C)
    g = jax.nn.sigmoid(pg) @ g_up
    return (jnp.sum(yn + bonus, axis=0) * g).astype(pr.dtype)


def hybrid_mixer(h, positions, w_in, rpb, mu_rkv, mu_w, mu_a, w0, w_up, a0, a_up, g_up,
                 k_k, k_a, r_k, gn_w, gn_b, w_branch, w_out):
    B, S, _ = h.shape
    proj = h @ w_in
    (aq, ak, av, nq, nk, nv, pr, pk, pv, pwf, pwb, paf, pab, pg, gz0, gz1, gz2) = jnp.split(
        proj, np.cumsum(IN_SPLITS)[:-1].tolist(), axis=-1)
    heads = lambda t: t.reshape(B, S, N_HEADS_MIX, HEAD_DIM)
    o_a = dilated_attention(partial_rotary(heads(aq), positions), partial_rotary(heads(ak), positions), heads(av))
    o_b = neighborhood_attention(heads(nq), heads(nk), heads(nv), rpb)
    o_c = rwkv7_bidirectional(pr, pk, pv, pwf, pwb, paf, pab, pg, mu_rkv, mu_w, mu_a,
                              w0, w_up, a0, a_up, g_up, k_k, k_a, r_k, gn_w, gn_b)
    merged = (jax.nn.sigmoid(gz0) * (o_a @ w_branch[0])
              + jax.nn.sigmoid(gz1) * (o_b @ w_branch[1])
              + jax.nn.sigmoid(gz2) * (o_c @ w_branch[2]))
    return merged @ w_out


def setup_inputs(seed: int = 0) -> dict:
    key = jax.random.key(seed)
    ks = jax.random.split(key, 28)
    L, D = DEPTH, D_MODEL
    f32 = jnp.float32
    nrm = lambda k, shape, scale: jax.random.normal(k, shape, f32) * scale
    x = nrm(ks[0], (BATCH, SEQ, D), 1.0)
    c = nrm(ks[1], (BATCH, D), 1.0)
    positions = (jnp.arange(SEQ, dtype=jnp.int32)[None, :]
                 + jax.random.randint(ks[2], (BATCH, 1), 0, 4096, dtype=jnp.int32))
    ada_w = nrm(ks[3], (L, D, N_MOD * D), 0.5 * D ** -0.5)
    ada_b = nrm(ks[4], (L, N_MOD * D), 0.02)
    norm_gains = 1.0 + nrm(ks[5], (L, 3, D), 0.05)
    ffn_wi = nrm(ks[6], (L, 2, D, 2 * D_FF), D ** -0.5)
    ffn_wo = nrm(ks[7], (L, 2, D_FF, D), D_FF ** -0.5)
    w_in = nrm(ks[8], (L, D, D_IN), D ** -0.5)
    rpb = nrm(ks[9], (L, N_HEADS_MIX, 2 * NA_WIN_ROWS - 1, 2 * NA_WIN_COLS - 1), 0.2)
    mu_rkv = jax.random.uniform(ks[10], (L, 2, 3, W_MIX), f32)
    mu_w = jax.random.uniform(ks[11], (L, 2, DECAY_LORA), f32)
    mu_a = jax.random.uniform(ks[12], (L, 2, ICLR_LORA), f32)
    w0 = nrm(ks[13], (L, 2, W_MIX), 1.5)
    w_up = nrm(ks[14], (L, 2, DECAY_LORA, W_MIX), DECAY_LORA ** -0.5)
    a0 = nrm(ks[15], (L, 2, W_MIX), 0.5)
    a_up = nrm(ks[16], (L, 2, ICLR_LORA, W_MIX), ICLR_LORA ** -0.5)
    g_up = nrm(ks[17], (L, GATE_LORA, W_MIX), GATE_LORA ** -0.5)
    k_k = 0.85 + nrm(ks[18], (L, W_MIX), 0.05)
    k_a = 1.0 + nrm(ks[19], (L, W_MIX), 0.05)
    r_k = nrm(ks[20], (L, N_HEADS_MIX, HEAD_DIM), 0.1)
    gn_w = 1.0 + nrm(ks[21], (L, W_MIX), 0.05)
    gn_b = nrm(ks[22], (L, W_MIX), 0.02)
    w_branch = nrm(ks[23], (L, N_BRANCH, W_MIX, D), W_MIX ** -0.5)
    w_out = nrm(ks[24], (L, D, D), D ** -0.5)
    final_norm = 1.0 + nrm(ks[25], (D,), 0.05)
    return {"x": x, "c": c, "positions": positions, "ada_w": ada_w, "ada_b": ada_b,
            "norm_gains": norm_gains, "ffn_wi": ffn_wi, "ffn_wo": ffn_wo, "w_in": w_in,
            "rpb": rpb, "mu_rkv": mu_rkv, "mu_w": mu_w, "mu_a": mu_a, "w0": w0, "w_up": w_up,
            "a0": a0, "a_up": a_up, "g_up": g_up, "k_k": k_k, "k_a": k_a, "r_k": r_k,
            "gn_w": gn_w, "gn_b": gn_b, "w_branch": w_branch, "w_out": w_out,
            "final_norm": final_norm}


def reference(x, c, positions, ada_w, ada_b, norm_gains, ffn_wi, ffn_wo, w_in, rpb,
              mu_rkv, mu_w, mu_a, w0, w_up, a0, a_up, g_up, k_k, k_a, r_k, gn_w, gn_b,
              w_branch, w_out, final_norm):
    cs = jax.nn.silu(c)
    for l in range(DEPTH):
        mod = cs @ ada_w[l] + ada_b[l]
        sh1, sc1, gt1, sh2, sc2, gt2, sh3, sc3, gt3 = jnp.split(mod, N_MOD, axis=-1)
        h = modulate(rmsnorm(x, norm_gains[l, 0]), sh1, sc1)
        x = x + 0.5 * gt1[:, None, :] * swiglu(h, ffn_wi[l, 0], ffn_wo[l, 0])
        h = modulate(rmsnorm(x, norm_gains[l, 1]), sh2, sc2)
        x = x + gt2[:, None, :] * hybrid_mixer(
            h, positions, w_in[l], rpb[l], mu_rkv[l], mu_w[l], mu_a[l], w0[l], w_up[l],
            a0[l], a_up[l], g_up[l], k_k[l], k_a[l], r_k[l], gn_w[l], gn_b[l],
            w_branch[l], w_out[l])
        h = modulate(rmsnorm(x, norm_gains[l, 2]), sh3, sc3)
        x = x + 0.5 * gt3[:, None, :] * swiglu(h, ffn_wi[l, 1], ffn_wo[l, 1])
    return rmsnorm(x, final_norm)
```

```cpp
#include <hip/hip_runtime.h>
#include <hip/hip_cooperative_groups.h>
#include <cstdio>
namespace cg = cooperative_groups;

#define LAS __attribute__((address_space(3)))
typedef unsigned short bf16_t;
typedef short bf16x8 __attribute__((ext_vector_type(8)));
typedef float f32x4 __attribute__((ext_vector_type(4)));
typedef unsigned u32x4 __attribute__((ext_vector_type(4)));
typedef unsigned u32x2 __attribute__((ext_vector_type(2)));
typedef float f32x2_ __attribute__((ext_vector_type(2)));

#ifndef MK_LAUNCHES
#define MK_LAUNCHES 1
#endif

constexpr int T_TOK = 32768, SEQ = 2048, DM = 1024, DFF = 2816, DEPTH = 4, NMOD = 9216;
constexpr size_t U1 = (size_t)T_TOK * 512;
constexpr int LDS_BYTES = 135168;

constexpr size_t W_WI1 = 0, W_WI2 = W_WI1 + 5632ull * 1024, W_WO1 = W_WI2 + 5632ull * 1024, W_WO2 = W_WO1 + 1024ull * 2816,
                 W_MIX = W_WO2 + 1024ull * 2816, W_G = W_MIX + 5120ull * 1024, W_BR = W_G + 3072ull * 1024, W_OUT = W_BR + 3ull * 1024 * 512,
                 W_GUP = W_OUT + 1024ull * 1024, W_TOTAL = W_GUP + 512ull * 256;

struct Params {
    const float *x, *c; const int* pos;
    const float *ada_w, *ada_b, *norm_g, *ffn_wi, *ffn_wo, *w_in, *rpb, *mu_rkv, *mu_w, *mu_a, *w0, *w_up, *a0, *a_up, *g_up, *k_k, *k_a, *r_k, *gn_w, *gn_b, *w_branch, *w_out, *final_norm;
    float* out;
    float* mod;
    float* rope;
    bf16_t* wb0; bf16_t* wb1;
    bf16_t* h;
    bf16_t* big;
    bf16_t* yd;
    bf16_t* part;
    float* lse;
    unsigned* bar;
};

__device__ __forceinline__ float bf2f(bf16_t v) { return __uint_as_float(((unsigned)v) << 16); }
__device__ __forceinline__ bf16_t f2bf(float f) { unsigned u = __float_as_uint(f); u += 0x7FFFu + ((u >> 16) & 1u); return (bf16_t)(u >> 16); }
typedef __bf16 bf16v2_t __attribute__((ext_vector_type(2)));
__device__ __forceinline__ unsigned pk_bf16(float lo, float hi) { const f32x2_ v = {lo, hi}; return __builtin_bit_cast(unsigned, __builtin_convertvector(v, bf16v2_t)); }
__device__ __forceinline__ float bflo(unsigned u) { return __uint_as_float(u << 16); }
__device__ __forceinline__ float bfhi(unsigned u) { return __uint_as_float(u & 0xffff0000u); }
__device__ __forceinline__ float sigmoidf_(float x) { return __builtin_amdgcn_rcpf(1.0f + __expf(-x)); }
__device__ __forceinline__ float tanhf_(float x) { return 1.0f - 2.0f * __builtin_amdgcn_rcpf(1.0f + __expf(2.0f * x)); }

namespace pg8 {
constexpr int BM = 256, BK = 64, HALF = 128, HTB = HALF * BK * 2, STAGE_BYTES = 8 * HTB, NXCD = 8, WGM = 8;
__device__ __forceinline__ int lds_byte(int r, int c) { const int st = (r >> 4) * 2 + (c >> 5), rr = r & 15, cc = c & 31, ob = rr * 64 + cc * 2; return st * 1024 + (ob ^ (((ob >> 9) & 1) << 5)); }
__device__ __forceinline__ void stage_rc(int b, int& R, int& C) { const int st = b / 1024, sb = b % 1024, swz = sb ^ (((sb >> 9) & 1) << 5); R = (st >> 1) * 16 + swz / 64; C = (st & 1) * 32 + (swz % 64) / 2; }
__device__ __forceinline__ int perm32(int rho) { const int n = rho >> 4, i = rho & 15; return 8 * (i >> 2) + 4 * n + (i & 3); }

struct Unit { int pm, pn, z; };
struct Gemm { const bf16_t* A; const bf16_t* Bt; int K, lda, ldb; size_t zA, zB; };

struct TileOrder {
    int nM, nN, nwg, G, c, nz;
    __device__ void init(int M, int N, int G_, int c_, int nz_) { nM = M / BM; nN = N / BM; nwg = nM * nN; G = G_; c = c_; nz = nz_; }
    __device__ bool next(int i, Unit& u) const {
        const int ti = i / nz; u.z = i - ti * nz;
        const long L = (long)ti * G + c; if (L >= nwg) return false;
        int wgid = (int)L; { const int q = nwg / NXCD, r = nwg % NXCD, xcd = wgid % NXCD, off = wgid / NXCD; wgid = (xcd < r ? xcd * (q + 1) : r * (q + 1) + (xcd - r) * q) + off; }
        const int nig = WGM * nN, gid = wgid / nig, fm = gid * WGM, gsz = (nM - fm) < WGM ? (nM - fm) : WGM;
        u.pm = fm + ((wgid % nig) % gsz); u.pn = (wgid % nig) / gsz; return true;
    }
};

template <class Epi>
__device__ __forceinline__ void gemm_phase(LAS unsigned char* lds, const Gemm g, const TileOrder& S, const Epi& E, const int tid) {
    const int wid = __builtin_amdgcn_readfirstlane(tid >> 6), lane = tid & 63, wr = wid >> 2, wc = wid & 3, fr = lane & 15, fq = lane >> 4;
    const int K = g.K, nt = K / BK;
    unsigned voffA[2], voffB[2];
#pragma unroll
    for (int i = 0; i < 2; ++i) { int R, C; stage_rc(tid * 16 + i * 8192, R, C); const int Rb = Epi::PERM ? ((R & ~31) + perm32(R & 31)) : R;
        voffA[i] = (unsigned)(R * g.lda + C) * 2u; voffB[i] = (unsigned)(Rb * g.ldb + C) * 2u; }
    const size_t kstep = (size_t)(BK * 2);
    const size_t hstepA = (size_t)HALF * g.lda * 2, hstepB = (size_t)HALF * g.ldb * 2;
    const size_t tstepA = 2 * hstepA, tstepB = 2 * hstepB;
    const unsigned ldsw = (unsigned)wid * 1024u;
    const int aoff = lds_byte(wr * 64 + fr, fq * 8), boff = lds_byte(wc * 32 + fr, fq * 8);
#define PG8_SA(b, h) (((b) * 2 + (h)) * HTB)
#define PG8_SB(b, h) ((4 + (b) * 2 + (h)) * HTB)
#define PG8_STAGE(bufoff, gbase, voff) do { _Pragma("unroll") for (int _i = 0; _i < 2; ++_i) \
        __builtin_amdgcn_global_load_lds((const unsigned*)((const char*)(gbase) + (voff)[_i]), (LAS unsigned*)(lds + (bufoff) + ldsw + _i * 8192), 16, 0, 0); } while (0)
#define PG8_LDA(dst, b, h) do { _Pragma("unroll") for (int m = 0; m < 4; ++m) _Pragma("unroll") for (int k = 0; k < 2; ++k) dst[m][k] = *(const LAS bf16x8*)(lds + PG8_SA(b, h) + aoff + m * 2048 + k * 1024); } while (0)
#define PG8_LDB(dst, b, h) do { _Pragma("unroll") for (int n = 0; n < 2; ++n) _Pragma("unroll") for (int k = 0; k < 2; ++k) dst[n][k] = *(const LAS bf16x8*)(lds + PG8_SB(b, h) + boff + n * 2048 + k * 1024); } while (0)
#define PG8_MMA(ai, bj, At, Bt) do { __builtin_amdgcn_s_setprio(1); _Pragma("unroll") for (int m = 0; m < 4; ++m) _Pragma("unroll") for (int n = 0; n < 2; ++n) _Pragma("unroll") for (int k = 0; k < 2; ++k) \
        acc[ai][bj][m][n] = __builtin_amdgcn_mfma_f32_16x16x32_bf16(Bt[n][k], At[m][k], acc[ai][bj][m][n], 0, 0, 0); __builtin_amdgcn_s_setprio(0); } while (0)
#define PG8_WAIT_V(n) asm volatile("s_waitcnt vmcnt(" #n ")" ::: "memory")
#define PG8_WAIT_L(n) asm volatile("s_waitcnt lgkmcnt(" #n ")" ::: "memory")
#define PG8_BAR __builtin_amdgcn_s_barrier()
#define PG8_SCHED __builtin_amdgcn_sched_barrier(0)
    Unit cur, nxt; int ui = 0;
    if (!S.next(0, cur)) return;
    f32x4 acc[2][2][4][2];
#pragma unroll
    for (int a = 0; a < 2; ++a)
#pragma unroll
        for (int b = 0; b < 2; ++b)
#pragma unroll
            for (int m = 0; m < 4; ++m)
#pragma unroll
                for (int n = 0; n < 2; ++n) acc[a][b][m][n] = (f32x4){0.f, 0.f, 0.f, 0.f};
    bf16x8 At[4][2], B0[2][2], B1[2][2];
    const char* cA = (const char*)g.A + (size_t)cur.z * g.zA + (size_t)cur.pm * tstepA; const char* cB = (const char*)g.Bt + (size_t)cur.z * g.zB + (size_t)cur.pn * tstepB;
    PG8_STAGE(PG8_SB(0, 0), cB, voffB); PG8_STAGE(PG8_SA(0, 0), cA, voffA); PG8_STAGE(PG8_SB(0, 1), cB + hstepB, voffB); PG8_STAGE(PG8_SA(0, 1), cA + hstepA, voffA);
    if (wr == 1) PG8_BAR;
    PG8_WAIT_V(4); PG8_BAR;
    PG8_STAGE(PG8_SB(1, 0), cB + kstep, voffB); PG8_STAGE(PG8_SA(1, 0), cA + kstep, voffA); PG8_STAGE(PG8_SB(1, 1), cB + hstepB + kstep, voffB);
    PG8_WAIT_V(6); PG8_BAR;
    for (;;) {
        const bool has_next = S.next(ui + 1, nxt);
        const char* nA = has_next ? (const char*)g.A + (size_t)nxt.z * g.zA + (size_t)nxt.pm * tstepA : cA; const char* nB = has_next ? (const char*)g.Bt + (size_t)nxt.z * g.zB + (size_t)nxt.pn * tstepB : cB;
#pragma nounroll
        for (int t = 0; t < nt; t += 2) {
            const bool last = (t == nt - 2);
            const char* a1 = cA + (size_t)(t + 1) * kstep;
            const char* a2 = last ? nA : cA + (size_t)(t + 2) * kstep; const char* b2 = last ? nB : cB + (size_t)(t + 2) * kstep;
            const char* a3 = a2 + kstep; const char* b3 = b2 + kstep;
            PG8_LDB(B0, 0, 0); PG8_SCHED; PG8_LDA(At, 0, 0); PG8_STAGE(PG8_SA(1, 1), a1 + hstepA, voffA);
            PG8_WAIT_L(8); PG8_BAR; PG8_WAIT_L(0); PG8_MMA(0, 0, At, B0); PG8_BAR; PG8_SCHED;
            PG8_LDB(B1, 0, 1); PG8_STAGE(PG8_SB(0, 0), b2, voffB);
            PG8_BAR; PG8_WAIT_L(0); PG8_MMA(0, 1, At, B1); PG8_BAR;
            PG8_LDA(At, 0, 1); PG8_STAGE(PG8_SA(0, 0), a2, voffA);
            PG8_BAR; PG8_WAIT_L(0); PG8_MMA(1, 0, At, B0); PG8_BAR; PG8_SCHED;
            PG8_STAGE(PG8_SB(0, 1), b2 + hstepB, voffB);
            PG8_WAIT_V(6); PG8_BAR; PG8_MMA(1, 1, At, B1); PG8_BAR;
            PG8_LDB(B0, 1, 0); PG8_SCHED; PG8_LDA(At, 1, 0); PG8_STAGE(PG8_SA(0, 1), a2 + hstepA, voffA);
            PG8_WAIT_L(8); PG8_BAR; PG8_WAIT_L(0); PG8_MMA(0, 0, At, B0); PG8_BAR; PG8_SCHED;
            PG8_LDB(B1, 1, 1); PG8_STAGE(PG8_SB(1, 0), b3, voffB);
            PG8_BAR; PG8_WAIT_L(0); PG8_MMA(0, 1, At, B1); PG8_BAR;
            PG8_LDA(At, 1, 1); PG8_STAGE(PG8_SA(1, 0), a3, voffA);
            PG8_BAR; PG8_WAIT_L(0); PG8_MMA(1, 0, At, B0); PG8_BAR; PG8_SCHED;
            PG8_STAGE(PG8_SB(1, 1), b3 + hstepB, voffB);
            PG8_WAIT_V(6); PG8_BAR; PG8_MMA(1, 1, At, B1); PG8_BAR;
        }
        E(acc, cur, wr, wc, fr, fq);
        if (!has_next) break;
#pragma unroll
        for (int a = 0; a < 2; ++a)
#pragma unroll
            for (int b = 0; b < 2; ++b)
#pragma unroll
                for (int m = 0; m < 4; ++m)
#pragma unroll
                    for (int n = 0; n < 2; ++n) acc[a][b][m][n] = (f32x4){0.f, 0.f, 0.f, 0.f};
        cur = nxt; cA = nA; cB = nB; ++ui;
    }
    PG8_WAIT_V(0);
    if (wr == 0) PG8_BAR;
    PG8_BAR;
#undef PG8_SA
#undef PG8_SB
#undef PG8_STAGE
#undef PG8_LDA
#undef PG8_LDB
#undef PG8_MMA
#undef PG8_WAIT_V
#undef PG8_WAIT_L
#undef PG8_BAR
#undef PG8_SCHED
}
}
using pg8::Unit;

typedef f32x4 Acc[2][2][4][2];

struct EpiSwiglu {
    static constexpr bool PERM = true;
    bf16_t* O;
    __device__ __forceinline__ void operator()(const Acc& acc, const Unit& u, int wr, int wc, int fr, int fq) const {
        const int row0 = u.pm * 256 + wr * 64 + fr, col0 = u.pn * 128 + wc * 32 + 8 * fq;
#pragma unroll
        for (int ai = 0; ai < 2; ++ai)
#pragma unroll
            for (int m = 0; m < 4; ++m) {
                bf16_t* rowp = O + (size_t)(row0 + ai * 128 + m * 16) * DFF + col0;
                float r[8];
#pragma unroll
                for (int n = 0; n < 2; ++n)
#pragma unroll
                    for (int j = 0; j < 4; ++j) { const float gt = acc[ai][0][m][n][j], up = acc[ai][1][m][n][j]; r[n * 4 + j] = gt * sigmoidf_(gt) * up; }
                u32x4 w; w.x = pk_bf16(r[0], r[1]); w.y = pk_bf16(r[2], r[3]); w.z = pk_bf16(r[4], r[5]); w.w = pk_bf16(r[6], r[7]);
                *(u32x4*)rowp = w;
            }
    }
};
struct EpiResid {
    static constexpr bool PERM = false;
    const float* xs; float* xd; const float* gate; float scale;
    __device__ __forceinline__ void operator()(const Acc& acc, const Unit& u, int wr, int wc, int fr, int fq) const {
        const int row0 = u.pm * 256 + wr * 64 + fr, col0 = u.pn * 256 + wc * 32 + 4 * fq, b = u.pm >> 3;
        f32x4 gv[2][2];
#pragma unroll
        for (int bj = 0; bj < 2; ++bj)
#pragma unroll
            for (int n = 0; n < 2; ++n) gv[bj][n] = *(const f32x4*)(gate + (size_t)b * NMOD + col0 + bj * 128 + n * 16) * scale;
#pragma unroll
        for (int am = 0; am < 4; ++am) {
            const int ai = am >> 1, m0 = (am & 1) * 2;
            f32x4 xv[2][2][2];
#pragma unroll
            for (int mm = 0; mm < 2; ++mm) {
                const size_t ro = (size_t)(row0 + ai * 128 + (m0 + mm) * 16) * DM + col0;
#pragma unroll
                for (int bj = 0; bj < 2; ++bj)
#pragma unroll
                    for (int n = 0; n < 2; ++n) xv[mm][bj][n] = *(const f32x4*)(xs + ro + bj * 128 + n * 16);
            }
#pragma unroll
            for (int mm = 0; mm < 2; ++mm) {
                const size_t ro = (size_t)(row0 + ai * 128 + (m0 + mm) * 16) * DM + col0;
#pragma unroll
                for (int bj = 0; bj < 2; ++bj)
#pragma unroll
                    for (int n = 0; n < 2; ++n) *(f32x4*)(xd + ro + bj * 128 + n * 16) = xv[mm][bj][n] + gv[bj][n] * acc[ai][bj][m0 + mm][n];
            }
        }
    }
};
struct EpiProj {
    static constexpr bool PERM = true;
    bf16_t* big; const float* rope;
    __device__ __forceinline__ void operator()(const Acc& acc, const Unit& u, int wr, int wc, int fr, int fq) const {
        const int bi = u.pn >> 1, colt = (u.pn & 1) * 256;
        bf16_t* base = big + (size_t)bi * U1;
        const int row0 = u.pm * 256 + wr * 64 + fr, col0 = colt + wc * 32 + 8 * fq;
        const bool rot = (bi == 0 || bi == 4) && ((wc & 1) == 0);
        const bool sg = (bi == 3) && (colt == 256);
#pragma unroll
        for (int am = 0; am < 4; ++am) {
            const int ai = am >> 1, m0 = (am & 1) * 2;
            f32x4 rc[2][4];
#pragma unroll
            for (int mm = 0; mm < 2; ++mm)
#pragma unroll
                for (int q = 0; q < 4; ++q) rc[mm][q] = (f32x4){0.f, 0.f, 0.f, 0.f};
            if (rot && fq < 2) {
#pragma unroll
                for (int mm = 0; mm < 2; ++mm) {
                    const float* rp = rope + (size_t)(row0 + ai * 128 + (m0 + mm) * 16) * 16;
#pragma unroll
                    for (int q = 0; q < 4; ++q) rc[mm][q] = *(const f32x4*)(rp + 4 * q);
                }
            }
#pragma unroll
            for (int mm = 0; mm < 2; ++mm) {
                const int m = m0 + mm;
                const int row = row0 + ai * 128 + m * 16;
                bf16_t* rowp = base + (size_t)row * 512 + col0;
#pragma unroll
                for (int bj = 0; bj < 2; ++bj) {
                    float r[8];
#pragma unroll
                    for (int n = 0; n < 2; ++n)
#pragma unroll
                        for (int j = 0; j < 4; ++j) r[n * 4 + j] = acc[ai][bj][m][n][j];
                    if (rot) {
                        float pr[8];
#pragma unroll
                        for (int j = 0; j < 8; ++j) pr[j] = __shfl_xor(r[j], 16);
                        if (fq < 2) {
                            const float sgn = fq == 0 ? -1.0f : 1.0f;
#pragma unroll
                            for (int j = 0; j < 4; ++j) { r[j] = r[j] * rc[mm][0][j] + sgn * pr[j] * rc[mm][2][j]; r[4 + j] = r[4 + j] * rc[mm][1][j] + sgn * pr[4 + j] * rc[mm][3][j]; }
                        }
                    }
                    if (sg) {
#pragma unroll
                        for (int j = 0; j < 8; ++j) r[j] = sigmoidf_(r[j]);
                    }
                    u32x4 w; w.x = pk_bf16(r[0], r[1]); w.y = pk_bf16(r[2], r[3]); w.z = pk_bf16(r[4], r[5]); w.w = pk_bf16(r[6], r[7]);
                    *(u32x4*)(rowp + bj * 128) = w;
                }
            }
        }
    }
};
struct EpiGates {
    static constexpr bool PERM = true;
    bf16_t* G0;
    __device__ __forceinline__ void operator()(const Acc& acc, const Unit& u, int wr, int wc, int fr, int fq) const {
        bf16_t* base = G0 + (size_t)(u.pn >> 2) * 2 * U1;
        const int row0 = u.pm * 256 + wr * 64 + fr, col0 = (u.pn & 3) * 256 + wc * 32 + 8 * fq;
#pragma unroll
        for (int ai = 0; ai < 2; ++ai)
#pragma unroll
            for (int m = 0; m < 4; ++m) {
                bf16_t* rowp = base + (size_t)(row0 + ai * 128 + m * 16) * 1024 + col0;
#pragma unroll
                for (int bj = 0; bj < 2; ++bj) {
                    float r[8];
#pragma unroll
                    for (int n = 0; n < 2; ++n)
#pragma unroll
                        for (int j = 0; j < 4; ++j) r[n * 4 + j] = sigmoidf_(acc[ai][bj][m][n][j]);
                    u32x4 w; w.x = pk_bf16(r[0], r[1]); w.y = pk_bf16(r[2], r[3]); w.z = pk_bf16(r[4], r[5]); w.w = pk_bf16(r[6], r[7]);
                    *(u32x4*)(rowp + bj * 128) = w;
                }
            }
    }
};
struct EpiBranch {
    static constexpr bool PERM = true;
    bf16_t* Mg; const bf16_t* G0;
    __device__ __forceinline__ void operator()(const Acc& acc, const Unit& u, int wr, int wc, int fr, int fq) const {
        const bf16_t* gate = G0 + (size_t)u.z * 2 * U1;
        const int row0 = u.pm * 256 + wr * 64 + fr, col0 = u.pn * 256 + wc * 32 + 8 * fq;
#pragma unroll
        for (int ai = 0; ai < 2; ++ai) {
            u32x4 gv[4][2], ov[4][2];
#pragma unroll
            for (int m = 0; m < 4; ++m) {
                const size_t ro = (size_t)(row0 + ai * 128 + m * 16) * 1024 + col0;
#pragma unroll
                for (int bj = 0; bj < 2; ++bj) {
                    gv[m][bj] = *(const u32x4*)(gate + ro + bj * 128);
                    ov[m][bj] = (u32x4){0u, 0u, 0u, 0u};
                    if (u.z != 0) ov[m][bj] = *(const u32x4*)(Mg + ro + bj * 128);
                }
            }
#pragma unroll
            for (int m = 0; m < 4; ++m) {
                const size_t ro = (size_t)(row0 + ai * 128 + m * 16) * 1024 + col0;
#pragma unroll
                for (int bj = 0; bj < 2; ++bj) {
                    float r[8];
#pragma unroll
                    for (int q = 0; q < 4; ++q) {
                        const int n = q >> 1, j = (q & 1) * 2;
                        r[2 * q] = bflo(ov[m][bj][q]) + bflo(gv[m][bj][q]) * acc[ai][bj][m][n][j];
                        r[2 * q + 1] = bfhi(ov[m][bj][q]) + bfhi(gv[m][bj][q]) * acc[ai][bj][m][n][j + 1];
                    }
                    u32x4 w; w.x = pk_bf16(r[0], r[1]); w.y = pk_bf16(r[2], r[3]); w.z = pk_bf16(r[4], r[5]); w.w = pk_bf16(r[6], r[7]);
                    *(u32x4*)(Mg + ro + bj * 128) = w;
                }
            }
        }
    }
};
struct EpiOc {
    static constexpr bool PERM = true;
    bf16_t* O; const bf16_t* yd;
    __device__ __forceinline__ void operator()(const Acc& acc, const Unit& u, int wr, int wc, int fr, int fq) const {
        const int row0 = u.pm * 256 + wr * 64 + fr, col0 = u.pn * 256 + wc * 32 + 8 * fq;
#pragma unroll
        for (int ai = 0; ai < 2; ++ai) {
            u32x4 y0[4][2], y1[4][2];
#pragma unroll
            for (int m = 0; m < 4; ++m) {
                const size_t ro = (size_t)(row0 + ai * 128 + m * 16) * 512 + col0;
#pragma unroll
                for (int bj = 0; bj < 2; ++bj) { y0[m][bj] = *(const u32x4*)(yd + ro + bj * 128); y1[m][bj] = *(const u32x4*)(yd + U1 + ro + bj * 128); }
            }
#pragma unroll
            for (int m = 0; m < 4; ++m) {
                const size_t ro = (size_t)(row0 + ai * 128 + m * 16) * 512 + col0;
#pragma unroll
                for (int bj = 0; bj < 2; ++bj) {
                    float r[8];
#pragma unroll
                    for (int q = 0; q < 4; ++q) {
                        const int n = q >> 1, j = (q & 1) * 2;
                        r[2 * q] = (bflo(y0[m][bj][q]) + bflo(y1[m][bj][q])) * acc[ai][bj][m][n][j];
                        r[2 * q + 1] = (bfhi(y0[m][bj][q]) + bfhi(y1[m][bj][q])) * acc[ai][bj][m][n][j + 1];
                    }
                    u32x4 w; w.x = pk_bf16(r[0], r[1]); w.y = pk_bf16(r[2], r[3]); w.z = pk_bf16(r[4], r[5]); w.w = pk_bf16(r[6], r[7]);
                    *(u32x4*)(O + ro + bj * 128) = w;
                }
            }
        }
    }
};

template <class Epi>
__device__ __forceinline__ void run_gemm(int tid_, int bid, unsigned char* lds, const bf16_t* A, int lda, size_t zA, const bf16_t* Bt, int ldb, size_t zB, int M, int N, int K, int nz, const Epi& E) {
    pg8::Gemm g; g.A = A; g.Bt = Bt; g.K = K; g.lda = lda; g.ldb = ldb; g.zA = zA; g.zB = zB;
    int tid = tid_; asm volatile("" : "+v"(tid));
    pg8::TileOrder S; S.init(M, N, (int)gridDim.x, bid, nz);
    pg8::gemm_phase<Epi>((LAS unsigned char*)lds, g, S, E, tid);
}

__device__ __forceinline__ int map_col(int id, int n) {
    if (id <= 1) { const int blk = n >> 8, w = n & 255; return (w >> 7) * DFF + blk * 128 + (w & 127); }
    if (id == 4) {
        const int bi = n >> 9, w = n & 511;
        int off;
        switch (bi) { case 0: off = 0; break; case 1: off = 1536; break; case 2: off = 3072; break; case 3: off = 4608; break; case 4: off = 512; break;
                      case 5: off = 1024; break; case 6: off = 2048; break; case 7: off = 2560; break; case 8: off = 3584; break; default: off = 4096; break; }
        if (bi == 3 && w >= 384) return -1;
        return off + w;
    }
    if (id == 5) return 4992 + n;
    return n;
}
__device__ void convert_layer(const int tid, const int bid, const Params& P, int l, bf16_t* wb, unsigned char* lds_raw) {
    float* tile = (float*)lds_raw;
    for (int it = bid; it < 3472; it += gridDim.x) {
        int id, t = it; const float* src; int ld, K, N; bf16_t* dst;
        if (t < 704) { id = 0; src = P.ffn_wi + ((size_t)l * 2 + 0) * 1024 * 5632; ld = 5632; K = 1024; N = 5632; dst = wb + W_WI1; }
        else if ((t -= 704) < 704) { id = 1; src = P.ffn_wi + ((size_t)l * 2 + 1) * 1024 * 5632; ld = 5632; K = 1024; N = 5632; dst = wb + W_WI2; }
        else if ((t -= 704) < 352) { id = 2; src = P.ffn_wo + ((size_t)l * 2 + 0) * 2816 * 1024; ld = 1024; K = 2816; N = 1024; dst = wb + W_WO1; }
        else if ((t -= 352) < 352) { id = 3; src = P.ffn_wo + ((size_t)l * 2 + 1) * 2816 * 1024; ld = 1024; K = 2816; N = 1024; dst = wb + W_WO2; }
        else if ((t -= 352) < 640) { id = 4; src = P.w_in + (size_t)l * 1024 * 8064; ld = 8064; K = 1024; N = 5120; dst = wb + W_MIX; }
        else if ((t -= 640) < 384) { id = 5; src = P.w_in + (size_t)l * 1024 * 8064; ld = 8064; K = 1024; N = 3072; dst = wb + W_G; }
        else if ((t -= 384) < 192) { id = 6; const int b = t / 64; t -= b * 64; src = P.w_branch + ((size_t)l * 3 + b) * 512 * 1024; ld = 1024; K = 512; N = 1024; dst = wb + W_BR + (size_t)b * 1024 * 512; }
        else if ((t -= 192) < 128) { id = 9; src = P.w_out + (size_t)l * 1024 * 1024; ld = 1024; K = 1024; N = 1024; dst = wb + W_OUT; }
        else { t -= 128; id = 10; src = P.g_up + (size_t)l * 128 * 512; ld = 512; K = 256; N = 512; dst = wb + W_GUP; }
        (void)N;
        const int nk = K >> 7, kt = t % nk, ntile = t / nk, k0 = kt * 128, n0 = ntile * 64;
        const int cbase = map_col(id, n0);
        const bool zero = (cbase < 0) || (id == 10 && k0 >= 128);
        const int lane = tid & 63, w = tid >> 6;
        __syncthreads();
        float v[16];
#pragma unroll
        for (int i = 0; i < 16; ++i) { const int k = w * 16 + i; v[i] = zero ? 0.f : src[(size_t)(k0 + k) * ld + cbase + lane]; }
#pragma unroll
        for (int i = 0; i < 16; ++i) tile[(w * 16 + i) * 65 + lane] = v[i];
        __syncthreads();
        const int n = tid >> 3, ks = (tid & 7) * 16;
        float r[16];
#pragma unroll
        for (int e2 = 0; e2 < 16; ++e2) r[e2] = tile[(ks + e2) * 65 + n];
        u32x4 w0, w1;
        w0.x = pk_bf16(r[0], r[1]); w0.y = pk_bf16(r[2], r[3]); w0.z = pk_bf16(r[4], r[5]); w0.w = pk_bf16(r[6], r[7]);
        w1.x = pk_bf16(r[8], r[9]); w1.y = pk_bf16(r[10], r[11]); w1.z = pk_bf16(r[12], r[13]); w1.w = pk_bf16(r[14], r[15]);
        bf16_t* dp = dst + (size_t)(n0 + n) * K + k0 + ks;
        *(u32x4*)dp = w0; *(u32x4*)(dp + 8) = w1;
    }
    __syncthreads();
}

__device__ void phase_mod(const int tid, const int bid, const Params& P, unsigned char* lds_raw) {
    float* cs = (float*)lds_raw;
    float* part = cs + 16384;
    for (int i = tid; i < 16384; i += 512) { const int b = i & 15, k = i >> 4; const float v = P.c[b * 1024 + k]; cs[k * 16 + b] = v * sigmoidf_(v); }
    __syncthreads();
    for (int item = bid; item < 288; item += gridDim.x) {
        const int l = item / 72, cb = item % 72, cl = tid & 127, kq = tid >> 7, col = cb * 128 + cl;
        float acc[16];
#pragma unroll
        for (int b = 0; b < 16; ++b) acc[b] = 0.f;
        const float* wp = P.ada_w + ((size_t)l * 1024 + kq * 256) * NMOD + col;
#pragma unroll 16
        for (int k = 0; k < 256; ++k) {
            const float w = wp[(size_t)k * NMOD];
            const f32x4* cv = (const f32x4*)(cs + (kq * 256 + k) * 16);
#pragma unroll
            for (int q = 0; q < 4; ++q) { const f32x4 c4 = cv[q]; acc[q * 4 + 0] += w * c4[0]; acc[q * 4 + 1] += w * c4[1]; acc[q * 4 + 2] += w * c4[2]; acc[q * 4 + 3] += w * c4[3]; }
        }
#pragma unroll
        for (int b = 0; b < 16; ++b) part[(kq * 16 + b) * 128 + cl] = acc[b];
        __syncthreads();
        for (int o = tid; o < 2048; o += 512) {
            const int b = o >> 7, cc = o & 127;
            const float s = part[(0 * 16 + b) * 128 + cc] + part[(1 * 16 + b) * 128 + cc] + part[(2 * 16 + b) * 128 + cc] + part[(3 * 16 + b) * 128 + cc] + P.ada_b[(size_t)l * NMOD + cb * 128 + cc];
            P.mod[((size_t)l * 16 + b) * NMOD + cb * 128 + cc] = s;
        }
        __syncthreads();
    }
    for (int i = bid * 512 + tid; i < T_TOK * 8; i += gridDim.x * 512) {
        const int t = i >> 3, f = i & 7;
        double invf;
        switch (f) { case 0: invf = 1.0; break; case 1: invf = 0.19392274474868576; break; case 2: invf = 0.03760603093086393; break; case 3: invf = 0.007292664737217109; break;
                     case 4: invf = 0.001414213562373095; break; case 5: invf = 0.0002742481756762073; break; case 6: invf = 5.318295896944988e-05; break; default: invf = 1.031338537721246e-05; break; }
        double rev = (double)P.pos[t] * invf * 0.15915494309189535;
        rev -= floor(rev);
        const float fr = (float)rev;
        P.rope[(size_t)t * 16 + f] = __builtin_amdgcn_cosf(fr);
        P.rope[(size_t)t * 16 + 8 + f] = __builtin_amdgcn_sinf(fr);
    }
}

__device__ void phase_norm(const int tid, const int bid, const float* xs, const float* g, const float* shift, const float* scale, bf16_t* h) {
    const int lane = tid & 63, wid = tid >> 6;
    for (int row = (bid * 8 + wid) * 4; row < T_TOK; row += gridDim.x * 32) {
        f32x4 v[4][4]; float ss[4] = {0.f, 0.f, 0.f, 0.f};
#pragma unroll
        for (int rr = 0; rr < 4; ++rr)
#pragma unroll
            for (int j = 0; j < 4; ++j) v[rr][j] = *(const f32x4*)(xs + (size_t)(row + rr) * DM + j * 256 + lane * 4);
        const int b = row >> 11;
        f32x4 gg[4], sc[4], sh[4];
#pragma unroll
        for (int j = 0; j < 4; ++j) {
            const int col = j * 256 + lane * 4;
            gg[j] = *(const f32x4*)(g + col); sc[j] = *(const f32x4*)(scale + (size_t)b * NMOD + col); sh[j] = *(const f32x4*)(shift + (size_t)b * NMOD + col);
        }
#pragma unroll
        for (int rr = 0; rr < 4; ++rr)
#pragma unroll
            for (int j = 0; j < 4; ++j) ss[rr] += v[rr][j][0] * v[rr][j][0] + v[rr][j][1] * v[rr][j][1] + v[rr][j][2] * v[rr][j][2] + v[rr][j][3] * v[rr][j][3];
#pragma unroll
        for (int o = 32; o >= 1; o >>= 1) {
#pragma unroll
            for (int rr = 0; rr < 4; ++rr) ss[rr] += __shfl_xor(ss[rr], o);
        }
#pragma unroll
        for (int rr = 0; rr < 4; ++rr) {
            const float rstd = rsqrtf(ss[rr] * (1.0f / 1024.0f) + 1e-6f);
#pragma unroll
            for (int j = 0; j < 4; ++j) {
                const int col = j * 256 + lane * 4;
                float r[4];
#pragma unroll
                for (int q = 0; q < 4; ++q) r[q] = v[rr][j][q] * rstd * gg[j][q] * (1.0f + sc[j][q]) + sh[j][q];
                u32x2 w; w.x = pk_bf16(r[0], r[1]); w.y = pk_bf16(r[2], r[3]);
                *(u32x2*)(h + (size_t)(row + rr) * DM + col) = w;
            }
        }
    }
}
__device__ void phase_final_norm(const int tid, const int bid, float* x, const float* g) {
    const int lane = tid & 63, wid = tid >> 6;
    for (int row = (bid * 8 + wid) * 4; row < T_TOK; row += gridDim.x * 32) {
        f32x4 v[4][4]; float ss[4] = {0.f, 0.f, 0.f, 0.f};
#pragma unroll
        for (int rr = 0; rr < 4; ++rr)
#pragma unroll
            for (int j = 0; j < 4; ++j) v[rr][j] = *(const f32x4*)(x + (size_t)(row + rr) * DM + j * 256 + lane * 4);
#pragma unroll
        for (int rr = 0; rr < 4; ++rr)
#pragma unroll
            for (int j = 0; j < 4; ++j) ss[rr] += v[rr][j][0] * v[rr][j][0] + v[rr][j][1] * v[rr][j][1] + v[rr][j][2] * v[rr][j][2] + v[rr][j][3] * v[rr][j][3];
#pragma unroll
        for (int o = 32; o >= 1; o >>= 1) {
#pragma unroll
            for (int rr = 0; rr < 4; ++rr) ss[rr] += __shfl_xor(ss[rr], o);
        }
#pragma unroll
        for (int rr = 0; rr < 4; ++rr) {
            const float rstd = rsqrtf(ss[rr] * (1.0f / 1024.0f) + 1e-6f);
#pragma unroll
            for (int j = 0; j < 4; ++j) { const f32x4 gg = *(const f32x4*)(g + j * 256 + lane * 4); *(f32x4*)(x + (size_t)(row + rr) * DM + j * 256 + lane * 4) = v[rr][j] * rstd * gg; }
        }
    }
}


typedef float f32x2 __attribute__((ext_vector_type(2)));
__device__ __forceinline__ void red16x2(float& a, float& b) {
    asm volatile("s_nop 1\n\t"
                 "v_add_f32_dpp %0, %0, %0 quad_perm:[1,0,3,2] row_mask:0xf bank_mask:0xf\n\t"
                 "v_add_f32_dpp %1, %1, %1 quad_perm:[1,0,3,2] row_mask:0xf bank_mask:0xf\n\t"
                 "s_nop 0\n\t"
                 "v_add_f32_dpp %0, %0, %0 quad_perm:[2,3,0,1] row_mask:0xf bank_mask:0xf\n\t"
                 "v_add_f32_dpp %1, %1, %1 quad_perm:[2,3,0,1] row_mask:0xf bank_mask:0xf\n\t"
                 "s_nop 0\n\t"
                 "v_add_f32_dpp %0, %0, %0 row_half_mirror row_mask:0xf bank_mask:0xf\n\t"
                 "v_add_f32_dpp %1, %1, %1 row_half_mirror row_mask:0xf bank_mask:0xf\n\t"
                 "s_nop 0\n\t"
                 "v_add_f32_dpp %0, %0, %0 row_mirror row_mask:0xf bank_mask:0xf\n\t"
                 "v_add_f32_dpp %1, %1, %1 row_mirror row_mask:0xf bank_mask:0xf\n\t"
                 "s_nop 0"
                 : "+v"(a), "+v"(b));
}
__device__ __forceinline__ void red8(float& a) {
    asm volatile("s_nop 1\n\t"
                 "v_add_f32_dpp %0, %0, %0 quad_perm:[1,0,3,2] row_mask:0xf bank_mask:0xf\n\t"
                 "s_nop 1\n\t"
                 "v_add_f32_dpp %0, %0, %0 quad_perm:[2,3,0,1] row_mask:0xf bank_mask:0xf\n\t"
                 "s_nop 1\n\t"
                 "v_add_f32_dpp %0, %0, %0 row_half_mirror row_mask:0xf bank_mask:0xf\n\t"
                 "s_nop 0"
                 : "+v"(a));
}
__device__ __forceinline__ void red8x4(float& a, float& b, float& c, float& d) {
    asm volatile("s_nop 1\n\t"
                 "v_add_f32_dpp %0, %0, %0 quad_perm:[1,0,3,2] row_mask:0xf bank_mask:0xf\n\t"
                 "v_add_f32_dpp %1, %1, %1 quad_perm:[1,0,3,2] row_mask:0xf bank_mask:0xf\n\t"
                 "v_add_f32_dpp %2, %2, %2 quad_perm:[1,0,3,2] row_mask:0xf bank_mask:0xf\n\t"
                 "v_add_f32_dpp %3, %3, %3 quad_perm:[1,0,3,2] row_mask:0xf bank_mask:0xf\n\t"
                 "v_add_f32_dpp %0, %0, %0 quad_perm:[2,3,0,1] row_mask:0xf bank_mask:0xf\n\t"
                 "v_add_f32_dpp %1, %1, %1 quad_perm:[2,3,0,1] row_mask:0xf bank_mask:0xf\n\t"
                 "v_add_f32_dpp %2, %2, %2 quad_perm:[2,3,0,1] row_mask:0xf bank_mask:0xf\n\t"
                 "v_add_f32_dpp %3, %3, %3 quad_perm:[2,3,0,1] row_mask:0xf bank_mask:0xf\n\t"
                 "v_add_f32_dpp %0, %0, %0 row_half_mirror row_mask:0xf bank_mask:0xf\n\t"
                 "v_add_f32_dpp %1, %1, %1 row_half_mirror row_mask:0xf bank_mask:0xf\n\t"
                 "v_add_f32_dpp %2, %2, %2 row_half_mirror row_mask:0xf bank_mask:0xf\n\t"
                 "v_add_f32_dpp %3, %3, %3 row_half_mirror row_mask:0xf bank_mask:0xf\n\t"
                 "s_nop 1"
                 : "+v"(a), "+v"(b), "+v"(c), "+v"(d));
}
constexpr int CH = 32;
__device__ __forceinline__ int sw_off(int row, int col) { return row * 128 + ((((col >> 3) ^ (row & 7))) << 4) + (col & 7) * 2; }
__device__ __forceinline__ bf16x8 sw_frag(const unsigned char* base, int row, int ks, int g4) { return *(const bf16x8*)(base + row * 128 + (((ks * 4 + g4) ^ (row & 7)) << 4)); }
__device__ __forceinline__ bf16_t bf1(float f) { return (bf16_t)(pk_bf16(f, 0.f) & 0xffffu); }
typedef short s16x4s __attribute__((ext_vector_type(4)));
__device__ __forceinline__ bf16x8 tr_frag(const unsigned char* base, int row0, int col0, int q15) {
    const int r1 = row0 + (q15 >> 2), r2 = r1 + 4, ch = (col0 >> 3) + ((q15 & 3) >> 1), sub = (q15 & 1) * 8;
    const s16x4s a = __builtin_amdgcn_ds_read_tr16_b64_v4i16((LAS s16x4s*)(base + r1 * 128 + ((ch ^ (r1 & 7)) << 4) + sub));
    const s16x4s b = __builtin_amdgcn_ds_read_tr16_b64_v4i16((LAS s16x4s*)(base + r2 * 128 + ((ch ^ (r2 & 7)) << 4) + sub));
    bf16x8 r; r[0] = a[0]; r[1] = a[1]; r[2] = a[2]; r[3] = a[3]; r[4] = b[0]; r[5] = b[1]; r[6] = b[2]; r[7] = b[3]; return r;
}
__device__ void phase_scan(const int tid, const int bid, const Params& P, int l, unsigned char* lds_raw) {
    unsigned char* WUT = lds_raw;
    unsigned char* AUT = lds_raw + 8192;
    float* s_v   = (float*)(lds_raw + 32768);
    float* s_t1  = (float*)(lds_raw + 40960);
    float* s_t2  = (float*)(lds_raw + 49152);
    float* s_y   = (float*)(lds_raw + 57344);
    float* s_rhs = (float*)(lds_raw + 65536);
    unsigned char* Xb  = lds_raw + 73728;
    unsigned char* Ybb = lds_raw + 81920;
    unsigned char* Vb  = lds_raw + 90112;
    unsigned char* UVT = lds_raw + 98304;
    unsigned char* S0b = lds_raw + 106496;
    unsigned char* AKf = lds_raw + 114688;
    unsigned char* RBK = lds_raw + 118784;
    float* Lf   = (float*)(lds_raw + 122880);
    float* s_gc = (float*)(lds_raw + 126976);
    float* s_bd = (float*)(lds_raw + 127232);
    float* s_wt = (float*)(lds_raw + 127488);
    const int lane = tid & 63, wid = __builtin_amdgcn_readfirstlane(tid >> 6), q15 = lane & 15, g4 = lane >> 4;
    const int tt = wid >> 1, j0 = (wid & 1) * 2; const bool isR = tt >= 2;
    const bf16_t* PR = P.big + 2 * U1; const bf16_t* PK = P.big + 8 * U1; const bf16_t* PV = P.big + 9 * U1; const bf16_t* LO = P.big + 3 * U1;
    for (int chain = bid; chain < 256; chain += gridDim.x) {
        const int d = chain >> 7, b = (chain >> 3) & 15, hd = chain & 7;
        __syncthreads();
        for (int i = tid; i < 4096; i += 512) {
            const int r = i >> 6, c = i & 63;
            *(bf16_t*)(WUT + sw_off(c, r)) = bf1(P.w_up[(((size_t)l * 2 + d) * 64 + r) * 512 + hd * 64 + c]);
            *(bf16_t*)(AUT + sw_off(c, r)) = bf1(P.a_up[(((size_t)l * 2 + d) * 64 + r) * 512 + hd * 64 + c]);
        }
        f32x4 St[2];
        St[0] = (f32x4){0.f, 0.f, 0.f, 0.f}; St[1] = St[0];
        const int tl = tid >> 4, c0 = (tid & 15) * 4;
        const int hc = hd * 64 + c0;
        const size_t pl = (size_t)l * 2 + d;
        u32x2 n_r2, n_k2, n_v2, n_rp2, n_kp2, n_vp2, n_w2, n_a2, n_wp2, n_ap2;
#define SCAN_LOAD_RAW(CHUNK) do { \
            const int tau_ = (CHUNK) * CH + tl; \
            const int s_ = d ? (SEQ - 1 - tau_) : tau_, sp_ = d ? s_ + 1 : s_ - 1; \
            const bool hasp_ = tau_ > 0; \
            const size_t row_ = (size_t)b * SEQ + s_, prow_ = (size_t)b * SEQ + (hasp_ ? sp_ : s_); \
            n_r2 = *(const u32x2*)(PR + row_ * 512 + hc); n_k2 = *(const u32x2*)(PK + row_ * 512 + hc); n_v2 = *(const u32x2*)(PV + row_ * 512 + hc); \
            n_rp2 = *(const u32x2*)(PR + prow_ * 512 + hc); n_kp2 = *(const u32x2*)(PK + prow_ * 512 + hc); n_vp2 = *(const u32x2*)(PV + prow_ * 512 + hc); \
            n_w2 = *(const u32x2*)(LO + row_ * 512 + d * 64 + c0); n_a2 = *(const u32x2*)(LO + row_ * 512 + 128 + d * 64 + c0); \
            n_wp2 = *(const u32x2*)(LO + prow_ * 512 + d * 64 + c0); n_ap2 = *(const u32x2*)(LO + prow_ * 512 + 128 + d * 64 + c0); \
            if (!hasp_) { n_rp2 = (u32x2){0u, 0u}; n_kp2 = n_rp2; n_vp2 = n_rp2; n_wp2 = n_rp2; n_ap2 = n_rp2; } } while (0)
        SCAN_LOAD_RAW(0);
        for (int chunk = 0; chunk < SEQ / CH; ++chunk) {
            int tidl = tid; asm volatile("" : "+v"(tidl));
            const int lane = tidl & 63, q15 = lane & 15, g4 = lane >> 4, tl = tidl >> 4, c0 = (tidl & 15) * 4, hc = hd * 64 + c0;
            const u32x2 r2 = n_r2, k2 = n_k2, v2 = n_v2, rp2 = n_rp2, kp2 = n_kp2, vp2 = n_vp2, w2 = n_w2, a2 = n_a2, wp2 = n_wp2, ap2 = n_ap2;
            const f32x4 mur = *(const f32x4*)(P.mu_rkv + (pl * 3 + 0) * 512 + hc), muk = *(const f32x4*)(P.mu_rkv + (pl * 3 + 1) * 512 + hc), muv = *(const f32x4*)(P.mu_rkv + (pl * 3 + 2) * 512 + hc);
            const f32x4 muw = *(const f32x4*)(P.mu_w + pl * 64 + c0), mua = *(const f32x4*)(P.mu_a + pl * 64 + c0);
            float rr[4], kk[4], vv[4], xw4[4], xa4_[4];
#pragma unroll
            for (int q = 0; q < 4; ++q) {
                const float rc = (q & 1) ? bfhi(r2[q >> 1]) : bflo(r2[q >> 1]), rpv = (q & 1) ? bfhi(rp2[q >> 1]) : bflo(rp2[q >> 1]);
                const float kc = (q & 1) ? bfhi(k2[q >> 1]) : bflo(k2[q >> 1]), kpv = (q & 1) ? bfhi(kp2[q >> 1]) : bflo(kp2[q >> 1]);
                const float vc = (q & 1) ? bfhi(v2[q >> 1]) : bflo(v2[q >> 1]), vpv = (q & 1) ? bfhi(vp2[q >> 1]) : bflo(vp2[q >> 1]);
                const float wc_ = (q & 1) ? bfhi(w2[q >> 1]) : bflo(w2[q >> 1]), wpv = (q & 1) ? bfhi(wp2[q >> 1]) : bflo(wp2[q >> 1]);
                const float ac = (q & 1) ? bfhi(a2[q >> 1]) : bflo(a2[q >> 1]), apv = (q & 1) ? bfhi(ap2[q >> 1]) : bflo(ap2[q >> 1]);
                rr[q] = rc + (rpv - rc) * mur[q]; kk[q] = kc + (kpv - kc) * muk[q]; vv[q] = vc + (vpv - vc) * muv[q];
                xw4[q] = tanhf_(wc_ + (wpv - wc_) * muw[q]);
                xa4_[q] = ac + (apv - ac) * mua[q];
                s_v[tl * 64 + c0 + q] = vv[q];
            }
            { u32x2 w; w.x = pk_bf16(xw4[0], xw4[1]); w.y = pk_bf16(xw4[2], xw4[3]); *(u32x2*)(Xb + sw_off(tl, c0)) = w;
              w.x = pk_bf16(xa4_[0], xa4_[1]); w.y = pk_bf16(xa4_[2], xa4_[3]); *(u32x2*)(Ybb + sw_off(tl, c0)) = w; }
            __syncthreads();
            {
                const int mat = wid >> 2, mt = (wid >> 1) & 1, ntb = (wid & 1) * 2;
                const unsigned char* Ai = mat ? Ybb : Xb; const unsigned char* Bi = mat ? AUT : WUT;
                const bf16x8 af0 = sw_frag(Ai, 16 * mt + q15, 0, g4), af1 = sw_frag(Ai, 16 * mt + q15, 1, g4);
                float* Cm = (mat ? s_t2 : s_t1) + (mt * 16 + 4 * g4) * 64 + ntb * 16 + q15;
#pragma unroll
                for (int i = 0; i < 2; ++i) {
                    f32x4 cv = __builtin_amdgcn_mfma_f32_16x16x32_bf16(af0, sw_frag(Bi, 16 * (ntb + i) + q15, 0, g4), (f32x4){0.f, 0.f, 0.f, 0.f}, 0, 0, 0);
                    cv = __builtin_amdgcn_mfma_f32_16x16x32_bf16(af1, sw_frag(Bi, 16 * (ntb + i) + q15, 1, g4), cv, 0, 0, 0);
#pragma unroll
                    for (int e = 0; e < 4; ++e) Cm[e * 64 + 16 * i] = cv[e];
                }
            }
            __syncthreads();
            float a_[4], b_[4], k2v[4], lw[4], pw[4];
            {
                const f32x4 wz = *(const f32x4*)(P.w0 + pl * 512 + hc) + *(const f32x4*)(s_t1 + tl * 64 + c0), az = *(const f32x4*)(P.a0 + pl * 512 + hc) + *(const f32x4*)(s_t2 + tl * 64 + c0);
                const f32x4 kkw = *(const f32x4*)(P.k_k + (size_t)l * 512 + hc), kaw = *(const f32x4*)(P.k_a + (size_t)l * 512 + hc), rkw = *(const f32x4*)(P.r_k + (size_t)l * 512 + hc);
                float kn[4], av[4], ssq = 0.f, bd = 0.f;
#pragma unroll
                for (int q = 0; q < 4; ++q) {
                    av[q] = sigmoidf_(az[q]);
                    kn[q] = kk[q] * kkw[q]; ssq += kn[q] * kn[q];
                    k2v[q] = kk[q] * (1.0f + (av[q] - 1.0f) * kaw[q]);
                    bd += rr[q] * k2v[q] * rkw[q];
                }
                red16x2(ssq, bd);
                const float inv = __builtin_amdgcn_rcpf(fmaxf(__builtin_amdgcn_sqrtf(ssq), 1e-12f));
#pragma unroll
                for (int q = 0; q < 4; ++q) {
                    const float kq_ = kn[q] * inv;
                    a_[q] = -kq_; b_[q] = kq_ * av[q];
                    lw[q] = -0.6065306597126334f * sigmoidf_(wz[q]);
                }
#pragma unroll
                for (int q = 0; q < 4; ++q) {
                    float x = lw[q];
                    float y = __shfl_up(x, 16); if (lane >= 16) x += y;
                    y = __shfl_up(x, 32); if (lane >= 32) x += y;
                    pw[q] = x;
                }
                if (lane >= 48) *(f32x4*)(s_wt + wid * 64 + c0) = (f32x4){pw[0], pw[1], pw[2], pw[3]};
                if ((tid & 15) == 0) s_bd[tl] = bd;
            }
            __syncthreads();
            {
                f32x4 g = (f32x4){pw[0], pw[1], pw[2], pw[3]};
                for (int w2 = 0; w2 < wid; ++w2) g += *(const f32x4*)(s_wt + w2 * 64 + c0);
                float xa4[4], xr4[4], yb4[4], yk4[4];
#pragma unroll
                for (int q = 0; q < 4; ++q) {
                    const float eg = __expf(g[q]), egx = __expf(g[q] - lw[q]), eng = __expf(-g[q]);
                    xa4[q] = a_[q] * egx; xr4[q] = rr[q] * eg; yb4[q] = b_[q] * eng; yk4[q] = k2v[q] * eng;
                    if (tl == 31) s_gc[c0 + q] = eg;
                }
                u32x2 w;
                w.x = pk_bf16(xa4[0], xa4[1]); w.y = pk_bf16(xa4[2], xa4[3]); *(u32x2*)(Xb + sw_off(tl, c0)) = w;
                w.x = pk_bf16(xr4[0], xr4[1]); w.y = pk_bf16(xr4[2], xr4[3]); *(u32x2*)(Xb + sw_off(32 + tl, c0)) = w;
                w.x = pk_bf16(yb4[0], yb4[1]); w.y = pk_bf16(yb4[2], yb4[3]); *(u32x2*)(Ybb + sw_off(tl, c0)) = w;
                w.x = pk_bf16(yk4[0], yk4[1]); w.y = pk_bf16(yk4[2], yk4[3]); *(u32x2*)(Ybb + sw_off(32 + tl, c0)) = w;
                w.x = pk_bf16(vv[0], vv[1]); w.y = pk_bf16(vv[2], vv[3]); *(u32x2*)(Vb + sw_off(tl, c0)) = w;
#pragma unroll
                for (int i = 0; i < 2; ++i) {
                    u32x2 ws; ws.x = pk_bf16(St[i][0], St[i][1]); ws.y = pk_bf16(St[i][2], St[i][3]);
                    *(u32x2*)(S0b + sw_off(16 * (j0 + i) + q15, 16 * tt + 4 * g4)) = ws;
                }
            }
            __syncthreads();
            { const int nc = chunk + 1 < SEQ / CH ? chunk + 1 : chunk; SCAN_LOAD_RAW(nc); }
            f32x4 XS[2];
            {
                const bf16x8 xf0 = sw_frag(Xb, 16 * tt + q15, 0, g4), xf1 = sw_frag(Xb, 16 * tt + q15, 1, g4);
                f32x4 G[2];
#pragma unroll
                for (int i = 0; i < 2; ++i) {
                    const int br = 16 * (j0 + i) + q15;
                    G[i] = __builtin_amdgcn_mfma_f32_16x16x32_bf16(xf0, sw_frag(Ybb, br, 0, g4), (f32x4){0.f, 0.f, 0.f, 0.f}, 0, 0, 0);
                    G[i] = __builtin_amdgcn_mfma_f32_16x16x32_bf16(xf1, sw_frag(Ybb, br, 1, g4), G[i], 0, 0, 0);
                    XS[i] = __builtin_amdgcn_mfma_f32_16x16x32_bf16(xf0, tr_frag(S0b, 8 * g4, 16 * (j0 + i), q15), (f32x4){0.f, 0.f, 0.f, 0.f}, 0, 0, 0);
                    XS[i] = __builtin_amdgcn_mfma_f32_16x16x32_bf16(xf1, tr_frag(S0b, 32 + 8 * g4, 16 * (j0 + i), q15), XS[i], 0, 0, 0);
                }
#pragma unroll
                for (int i = 0; i < 2; ++i) {
                    const int yr = 16 * (j0 + i) + q15, j = yr & 31; const bool isK = (j0 + i) >= 2;
#pragma unroll
                    for (int e = 0; e < 4; ++e) {
                        const int t = (16 * tt + 4 * g4 + e) & 31;
                        const bool keep = isR ? (j <= t) : (j < t);
                        const float val = keep ? G[i][e] : 0.f;
                        if (!isR) { if (!isK) Lf[t * 32 + j] = val; else *(bf16_t*)(AKf + sw_off(t, 32 + j)) = bf1(val); }
                        else *(bf16_t*)(RBK + sw_off(t, (isK ? 32 : 0) + j)) = bf1(val);
                    }
                }
            }
            __syncthreads();
            {
                const int trow = 16 * (tt & 1) + q15;
                const bf16x8 af = sw_frag(isR ? RBK : AKf, trow, 1, g4);
                const bf16x8 uf1 = tr_frag(Vb, 8 * g4, 16 * tt, q15);
#pragma unroll
                for (int i = 0; i < 2; ++i) {
                    XS[i] = __builtin_amdgcn_mfma_f32_16x16x32_bf16(af, tr_frag(Vb, 8 * g4, 16 * (j0 + i), q15), XS[i], 0, 0, 0);
                    St[i] = __builtin_amdgcn_mfma_f32_16x16x32_bf16(uf1, tr_frag(Ybb, 32 + 8 * g4, 16 * (j0 + i), q15), St[i], 0, 0, 0);
                }
                if (!isR) {
#pragma unroll
                    for (int i = 0; i < 2; ++i)
#pragma unroll
                        for (int e = 0; e < 4; ++e) s_rhs[(16 * tt + 4 * g4 + e) * 64 + 16 * (j0 + i) + q15] = XS[i][e];
                }
            }
            __syncthreads();
            {
                const int m8 = lane & 7, vs_ = 8 * wid + (lane >> 3);
                const float* Lr = Lf + 4 * m8; const float* Rr = s_rhs + vs_;
                float uo[4] = {0.f, 0.f, 0.f, 0.f};
                float rown[4];
#pragma unroll
                for (int q = 0; q < 4; ++q) rown[q] = Rr[(4 * m8 + q) * 64];
#pragma unroll
                for (int tg = 0; tg < 4; ++tg) {
                    f32x4 l4[8];
#pragma unroll
                    for (int r8 = 0; r8 < 8; ++r8) l4[r8] = *(const f32x4*)(Lr + (8 * tg + r8) * 32);
#pragma unroll
                    for (int hg = 0; hg < 2; ++hg) {
                        const int k = 2 * tg + hg;
                        float p[4];
#pragma unroll
                        for (int r = 0; r < 4; ++r) {
                            const f32x4 lv = l4[4 * hg + r];
                            p[r] = lv[0] * uo[0] + lv[1] * uo[1] + lv[2] * uo[2] + lv[3] * uo[3];
                        }
                        red8x4(p[0], p[1], p[2], p[3]);
                        const f32x4 l1 = l4[4 * hg + 1], l2 = l4[4 * hg + 2], l3 = l4[4 * hg + 3];
                        const float u0 = rown[0] + p[0];
                        const float u1 = rown[1] + p[1] + l1[0] * u0;
                        const float u2 = rown[2] + p[2] + l2[0] * u0 + l2[1] * u1;
                        const float u3 = rown[3] + p[3] + l3[0] * u0 + l3[1] * u1 + l3[2] * u2;
                        const bool own = (m8 == k);
                        uo[0] = own ? u0 : uo[0]; uo[1] = own ? u1 : uo[1]; uo[2] = own ? u2 : uo[2]; uo[3] = own ? u3 : uo[3];
                    }
                    __builtin_amdgcn_sched_barrier(0);
                }
                u32x2 w; w.x = pk_bf16(uo[0], uo[1]); w.y = pk_bf16(uo[2], uo[3]);
                *(u32x2*)(UVT + sw_off(vs_, 4 * m8)) = w;
            }
            __syncthreads();
            {
                const bf16x8 uf0 = sw_frag(UVT, 16 * tt + q15, 0, g4);
                if (isR) {
                    const bf16x8 af0 = sw_frag(RBK, 16 * (tt & 1) + q15, 0, g4);
#pragma unroll
                    for (int i = 0; i < 2; ++i) XS[i] = __builtin_amdgcn_mfma_f32_16x16x32_bf16(af0, sw_frag(UVT, 16 * (j0 + i) + q15, 0, g4), XS[i], 0, 0, 0);
#pragma unroll
                    for (int i = 0; i < 2; ++i)
#pragma unroll
                        for (int e = 0; e < 4; ++e) s_y[(16 * (tt & 1) + 4 * g4 + e) * 64 + 16 * (j0 + i) + q15] = XS[i][e];
                }
#pragma unroll
                for (int i = 0; i < 2; ++i) {
                    St[i] = __builtin_amdgcn_mfma_f32_16x16x32_bf16(uf0, tr_frag(Ybb, 8 * g4, 16 * (j0 + i), q15), St[i], 0, 0, 0);
                    St[i] = St[i] * s_gc[16 * (j0 + i) + q15];
                }
            }
            __syncthreads();
            {
                const int tau = chunk * CH + tl;
                const int s = d ? (SEQ - 1 - tau) : tau;
                const size_t row = (size_t)b * SEQ + s;
                const f32x4 y4 = *(const f32x4*)(s_y + tl * 64 + c0), v4 = *(const f32x4*)(s_v + tl * 64 + c0);
                float sm = y4[0] + y4[1] + y4[2] + y4[3];
                { float dummy_ = 0.f; red16x2(sm, dummy_); }
                const float mean = sm * (1.0f / 64.0f);
                float vs = 0.f;
#pragma unroll
                for (int q = 0; q < 4; ++q) { const float dd = y4[q] - mean; vs += dd * dd; }
                { float dummy_ = 0.f; red16x2(vs, dummy_); }
                const float rs = rsqrtf(vs * (1.0f / 64.0f) + 64e-5f);
                const f32x4 gw = *(const f32x4*)(P.gn_w + (size_t)l * 512 + hc), gb = *(const f32x4*)(P.gn_b + (size_t)l * 512 + hc);
                const float bd = s_bd[tl];
                float o4[4];
#pragma unroll
                for (int q = 0; q < 4; ++q) o4[q] = (y4[q] - mean) * rs * gw[q] + gb[q] + bd * v4[q];
                u32x2 w; w.x = pk_bf16(o4[0], o4[1]); w.y = pk_bf16(o4[2], o4[3]);
                *(u32x2*)(P.yd + (size_t)d * U1 + row * 512 + hc) = w;
                __syncthreads();
            }
        }
    }
}

__device__ __forceinline__ void load_row64(const bf16_t* p, float* o) {
#pragma unroll
    for (int c = 0; c < 8; ++c) {
        const u32x4 v = *(const u32x4*)(p + c * 8);
#pragma unroll
        for (int q = 0; q < 4; ++q) { o[c * 8 + 2 * q] = bflo(v[q]); o[c * 8 + 2 * q + 1] = bfhi(v[q]); }
    }
}
__device__ void phase_attn_simple(const int tid, const int bid, const Params& P, int l, const int lo, const int hi) {
    bf16_t* AQ = P.big; const bf16_t* AK = P.big + 4 * U1; const bf16_t* AV = P.big + 5 * U1;
    bf16_t* NQ = P.big + U1; const bf16_t* NK = P.big + 6 * U1; const bf16_t* NV = P.big + 7 * U1;
    for (int idx = lo * 262144 + bid * 512 + tid; idx < hi * 262144; idx += gridDim.x * 512) {
        const int which = idx >> 18, i2 = idx & 262143, tok = i2 >> 3, hd = i2 & 7, b = tok >> 11, s = tok & 2047;
        bf16_t* qp = (which ? NQ : AQ) + (size_t)tok * 512 + hd * 64;
        const bf16_t* Kb = (which ? NK : AK) + (size_t)b * SEQ * 512 + hd * 64;
        const bf16_t* Vb = (which ? NV : AV) + (size_t)b * SEQ * 512 + hd * 64;
        float q[64], acc[64];
        load_row64(qp, q);
#pragma unroll
        for (int i = 0; i < 64; ++i) { q[i] *= 0.125f; acc[i] = 0.f; }
        float mx = -1e30f, den = 0.f;
        const int nkeys = which ? 128 : 387;
        const int r = s >> 6, cc = s & 63;
        const int rs = min(max(r - 4, 0), 24), cs = min(max(cc - 8, 0), 48);
        for (int e = 0; e < nkeys; ++e) {
            int sk; float bias = 0.f;
            if (which) {
                const int i = e >> 4, j = e & 15, kr = rs + i, kc = cs + j;
                sk = kr * 64 + kc;
                bias = P.rpb[(((size_t)l * 8 + hd) * 15 + (kr - r + 7)) * 31 + (kc - cc + 15)];
            } else {
                const int g = e / 129, off = e - g * 129 - 64;
                sk = s + (off << (2 * g));
                if (sk < 0 || sk >= SEQ) continue;
            }
            const bf16_t* kp = Kb + (size_t)sk * 512;
            float sc = bias;
#pragma unroll
            for (int c = 0; c < 8; ++c) {
                const u32x4 v = *(const u32x4*)(kp + c * 8);
#pragma unroll
                for (int qd = 0; qd < 4; ++qd) { sc += q[c * 8 + 2 * qd] * bflo(v[qd]); sc += q[c * 8 + 2 * qd + 1] * bfhi(v[qd]); }
            }
            if (sc > mx) {
                const float corr = __expf(mx - sc);
                den *= corr;
#pragma unroll
                for (int i = 0; i < 64; ++i) acc[i] *= corr;
                mx = sc;
            }
            const float p = __expf(sc - mx);
            den += p;
            const bf16_t* vp = Vb + (size_t)sk * 512;
#pragma unroll
            for (int c = 0; c < 8; ++c) {
                const u32x4 v = *(const u32x4*)(vp + c * 8);
#pragma unroll
                for (int qd = 0; qd < 4; ++qd) { acc[c * 8 + 2 * qd] += p * bflo(v[qd]); acc[c * 8 + 2 * qd + 1] += p * bfhi(v[qd]); }
            }
        }
        const float inv = 1.0f / den;
#pragma unroll
        for (int c = 0; c < 8; ++c) {
            u32x4 w;
#pragma unroll
            for (int qd = 0; qd < 4; ++qd) w[qd] = pk_bf16(acc[c * 8 + 2 * qd] * inv, acc[c * 8 + 2 * qd + 1] * inv);
            *(u32x4*)(qp + c * 8) = w;
        }
    }
}


typedef short s16x4 __attribute__((ext_vector_type(4)));
__device__ __forceinline__ bf16x8 tr_pair(const unsigned char* p0, const unsigned char* p1) {
    const s16x4 a = __builtin_amdgcn_ds_read_tr16_b64_v4i16((LAS s16x4*)p0);
    const s16x4 b = __builtin_amdgcn_ds_read_tr16_b64_v4i16((LAS s16x4*)p1);
    bf16x8 r; r[0] = a[0]; r[1] = a[1]; r[2] = a[2]; r[3] = a[3]; r[4] = b[0]; r[5] = b[1]; r[6] = b[2]; r[7] = b[3]; return r;
}
__device__ void phase_attnA(const int tid, const int bid, const Params& P, unsigned char* lds) {
    const bf16_t* AQ = P.big; const bf16_t* AK = P.big + 4 * U1; const bf16_t* AV = P.big + 5 * U1;
    unsigned char* sK = lds; unsigned char* sV = lds + 272 * 128;
    const int lane = tid & 63, wid = __builtin_amdgcn_readfirstlane(tid >> 6), q15 = lane & 15, g = lane >> 4;
    u32x4 pkv[5], pvv[5]; bf16x8 pq[2];
#define ATTNA_FETCH(UNIT) do { \
        const int pat_ = (UNIT) >> 11, rem_ = (UNIT) & 2047, b_ = rem_ >> 7, hd_ = (rem_ >> 4) & 7, sub_ = rem_ & 15; \
        const int shift_ = 2 * pat_, L_ = SEQ >> shift_; \
        const int j_ = pat_ == 0 ? 0 : (pat_ == 1 ? (sub_ >> 2) : sub_), i0_ = pat_ == 0 ? sub_ * 128 : (pat_ == 1 ? (sub_ & 3) * 128 : 0); \
        const size_t tb_ = (size_t)b_ * SEQ; \
        _Pragma("unroll") for (int it = 0; it < 5; ++it) { \
            const int c = tid + it * 512, r = c >> 3, ch = c & 7, i = i0_ - 64 + r; \
            pkv[it] = (u32x4){0u, 0u, 0u, 0u}; pvv[it] = pkv[it]; \
            if (c < 272 * 8 && i >= 0 && i < L_) { const size_t o = (tb_ + ((size_t)i << shift_) + j_) * 512 + hd_ * 64 + ch * 8; pkv[it] = *(const u32x4*)(AK + o); pvv[it] = *(const u32x4*)(AV + o); } } \
        const size_t qt_ = tb_ + ((size_t)(i0_ + 16 * wid + q15) << shift_) + j_; \
        pq[0] = *(const bf16x8*)(AQ + qt_ * 512 + hd_ * 64 + g * 8); pq[1] = *(const bf16x8*)(AQ + qt_ * 512 + hd_ * 64 + 32 + g * 8); } while (0)
    if (bid < 6144) ATTNA_FETCH(bid);
    for (int unit = bid; unit < 6144; unit += gridDim.x) {
        const int pat = unit >> 11, rem = unit & 2047, b = rem >> 7, hd = (rem >> 4) & 7, sub = rem & 15;
        const int shift = 2 * pat, L = SEQ >> shift;
        const int j = pat == 0 ? 0 : (pat == 1 ? (sub >> 2) : sub), i0 = pat == 0 ? sub * 128 : (pat == 1 ? (sub & 3) * 128 : 0);
        const size_t tb = (size_t)b * SEQ;
        __syncthreads();
#pragma unroll
        for (int it = 0; it < 5; ++it) {
            const int c = tid + it * 512, r = c >> 3, ch = c & 7;
            const int off = r * 128 + ((ch ^ (r & 7)) << 4);
            if (c < 272 * 8) { *(u32x4*)(sK + off) = pkv[it]; *(u32x4*)(sV + off) = pvv[it]; }
        }
        const int qi = i0 + 16 * wid + q15;
        const size_t qtok = tb + ((size_t)qi << shift) + j;
        bf16x8 qf[2];
        qf[0] = pq[0]; qf[1] = pq[1];
        __syncthreads();
        if (unit + (int)gridDim.x < 6144) ATTNA_FETCH(unit + (int)gridDim.x);
        f32x4 sc[10];
        const int k0w = i0 - 64 + 16 * wid;
#define ATTNA_TV(KT) ((k0w + 16 * (KT) + 15 >= 0) && (k0w + 16 * (KT) < L))
#pragma unroll
        for (int kt = 0; kt < 9; ++kt) {
            sc[kt] = (f32x4){0.f, 0.f, 0.f, 0.f};
            if (ATTNA_TV(kt)) {
                const int row = 16 * (wid + kt) + q15;
#pragma unroll
                for (int ks = 0; ks < 2; ++ks) {
                    const bf16x8 kf = *(const bf16x8*)(sK + row * 128 + (((ks * 4 + g) ^ (row & 7)) << 4));
                    sc[kt] = __builtin_amdgcn_mfma_f32_16x16x32_bf16(kf, qf[ks], sc[kt], 0, 0, 0);
                }
            }
        }
        float mx = -1e30f;
        const int gq = 4 * g - q15, kbase = qi - 64 + gq;
#pragma unroll
        for (int kt = 0; kt < 9; ++kt) {
            if (ATTNA_TV(kt)) {
#pragma unroll
                for (int e = 0; e < 4; ++e) {
                    const int ki = kbase + 16 * kt + e;
                    bool valid = (unsigned)ki < (unsigned)L;
                    if (kt == 0) valid = valid && (gq + e >= 0);
                    if (kt == 8) valid = valid && (gq + e <= 0);
                    const float s = valid ? sc[kt][e] * 0.125f : -1e30f;
                    sc[kt][e] = s; mx = fmaxf(mx, s);
                }
            }
        }
        mx = fmaxf(mx, __shfl_xor(mx, 16)); mx = fmaxf(mx, __shfl_xor(mx, 32));
        float den = 0.f;
#pragma unroll
        for (int kt = 0; kt < 9; ++kt) {
            if (ATTNA_TV(kt)) {
#pragma unroll
                for (int e = 0; e < 4; ++e) { const float p = __expf(sc[kt][e] - mx); sc[kt][e] = p; den += p; }
            } else sc[kt] = (f32x4){0.f, 0.f, 0.f, 0.f};
        }
        sc[9] = (f32x4){0.f, 0.f, 0.f, 0.f};
        den += __shfl_xor(den, 16); den += __shfl_xor(den, 32);
        f32x4 o[4];
#pragma unroll
        for (int nt = 0; nt < 4; ++nt) o[nt] = (f32x4){0.f, 0.f, 0.f, 0.f};
#pragma unroll
        for (int t2 = 0; t2 < 5; ++t2) {
            if (!(ATTNA_TV(2 * t2) || (2 * t2 + 1 < 9 && ATTNA_TV(2 * t2 + 1)))) continue;
            union { bf16x8 v; unsigned u[4]; } pf;
            pf.u[0] = pk_bf16(sc[2 * t2][0], sc[2 * t2][1]); pf.u[1] = pk_bf16(sc[2 * t2][2], sc[2 * t2][3]);
            pf.u[2] = pk_bf16(sc[2 * t2 + 1][0], sc[2 * t2 + 1][1]); pf.u[3] = pk_bf16(sc[2 * t2 + 1][2], sc[2 * t2 + 1][3]);
            const int vrow = 16 * (wid + 2 * t2) + 4 * g + (q15 >> 2);
#pragma unroll
            for (int nt = 0; nt < 4; ++nt) {
                const unsigned char* a1 = sV + vrow * 128 + (((nt * 2 + ((q15 & 3) >> 1)) ^ (vrow & 7)) << 4) + (q15 & 1) * 8;
                const bf16x8 vf = tr_pair(a1, a1 + 16 * 128);
                o[nt] = __builtin_amdgcn_mfma_f32_16x16x32_bf16(vf, pf.v, o[nt], 0, 0, 0);
            }
        }
        const float inv = 1.0f / den;
        bf16_t* op = P.part + (size_t)pat * U1 + qtok * 512 + hd * 64 + 4 * g;
#pragma unroll
        for (int nt = 0; nt < 4; ++nt) { u32x2 w; w.x = pk_bf16(o[nt][0] * inv, o[nt][1] * inv); w.y = pk_bf16(o[nt][2] * inv, o[nt][3] * inv); *(u32x2*)(op + nt * 16) = w; }
        if (g == 0) P.lse[((size_t)pat * T_TOK + qtok) * 8 + hd] = mx + __logf(den);
    }
}

__device__ void phase_attnB(const int tid, const int bid, const Params& P, const int l, unsigned char* lds) {
    bf16_t* NQ = P.big + U1; const bf16_t* NK = P.big + 6 * U1; const bf16_t* NV = P.big + 7 * U1;
    unsigned char* sV = lds; float* s_tab = (float*)(lds + 65536); float* s_mg = (float*)(lds + 65536 + 2048);
    const int lane = tid & 63, wid = __builtin_amdgcn_readfirstlane(tid >> 6), q15 = lane & 15, g = lane >> 4, qt = wid & 3, kh = wid >> 2;
    for (int unit = bid; unit < 4096; unit += gridDim.x) {
        const int b = unit >> 8, hd = (unit >> 5) & 7, r = unit & 31;
        const int rs = min(max(r - 4, 0), 24);
        const size_t tb = (size_t)b * SEQ;
        __syncthreads();
        {
            u32x4 vv[8];
#pragma unroll
            for (int it = 0; it < 8; ++it) { const int c = tid + it * 512, row = c >> 3, ch = c & 7; vv[it] = *(const u32x4*)(NV + (tb + rs * 64 + row) * 512 + hd * 64 + ch * 8); }
#pragma unroll
            for (int it = 0; it < 8; ++it) { const int c = tid + it * 512, row = c >> 3, ch = c & 7; *(u32x4*)(sV + row * 128 + ((ch ^ (row & 7)) << 4)) = vv[it]; }
        }
        if (tid < 465) s_tab[tid] = P.rpb[((size_t)l * 8 + hd) * 465 + tid];
        const int cq = 16 * qt + q15;
        const size_t qtok = tb + r * 64 + cq;
        bf16x8 qf[2];
        qf[0] = *(const bf16x8*)(NQ + qtok * 512 + hd * 64 + g * 8); qf[1] = *(const bf16x8*)(NQ + qtok * 512 + hd * 64 + 32 + g * 8);
        const int cb = min(max(16 * qt - 8, 0), 32);
        f32x4 sc[8];
#pragma unroll
        for (int ti = 0; ti < 8; ++ti) {
            const int krl = ti >> 1, ct = ti & 1;
            const size_t ktok = tb + (rs + 4 * kh + krl) * 64 + cb + 16 * ct + q15;
            sc[ti] = (f32x4){0.f, 0.f, 0.f, 0.f};
#pragma unroll
            for (int ks = 0; ks < 2; ++ks) {
                const bf16x8 kf = *(const bf16x8*)(NK + ktok * 512 + hd * 64 + ks * 32 + g * 8);
                sc[ti] = __builtin_amdgcn_mfma_f32_16x16x32_bf16(kf, qf[ks], sc[ti], 0, 0, 0);
            }
        }
        __syncthreads();
        const int cs = min(max(cq - 8, 0), 48);
        float mx = -1e30f;
        const int kcb = cb + 4 * g, rel = kcb - cs, bb = (rs + 4 * kh - r + 7) * 31 + (kcb - cq + 15);
#pragma unroll
        for (int ti = 0; ti < 8; ++ti)
#pragma unroll
            for (int e = 0; e < 4; ++e) {
                const int krl = ti >> 1, off = 16 * (ti & 1) + e;
                const bool valid = (unsigned)(rel + off) < 16u;
                const float bias = s_tab[valid ? bb + krl * 31 + off : 0];
                const float s = valid ? sc[ti][e] * 0.125f + bias : -1e30f;
                sc[ti][e] = s; mx = fmaxf(mx, s);
            }
        mx = fmaxf(mx, __shfl_xor(mx, 16)); mx = fmaxf(mx, __shfl_xor(mx, 32));
        float den = 0.f;
#pragma unroll
        for (int ti = 0; ti < 8; ++ti)
#pragma unroll
            for (int e = 0; e < 4; ++e) { const float p = __expf(sc[ti][e] - mx); sc[ti][e] = p; den += p; }
        den += __shfl_xor(den, 16); den += __shfl_xor(den, 32);
        f32x4 o[4];
#pragma unroll
        for (int nt = 0; nt < 4; ++nt) o[nt] = (f32x4){0.f, 0.f, 0.f, 0.f};
#pragma unroll
        for (int krl = 0; krl < 4; ++krl) {
            union { bf16x8 v; unsigned u[4]; } pf;
            pf.u[0] = pk_bf16(sc[2 * krl][0], sc[2 * krl][1]); pf.u[1] = pk_bf16(sc[2 * krl][2], sc[2 * krl][3]);
            pf.u[2] = pk_bf16(sc[2 * krl + 1][0], sc[2 * krl + 1][1]); pf.u[3] = pk_bf16(sc[2 * krl + 1][2], sc[2 * krl + 1][3]);
            const int vrow = (4 * kh + krl) * 64 + cb + 4 * g + (q15 >> 2);
#pragma unroll
            for (int nt = 0; nt < 4; ++nt) {
                const unsigned char* a1 = sV + vrow * 128 + (((nt * 2 + ((q15 & 3) >> 1)) ^ (vrow & 7)) << 4) + (q15 & 1) * 8;
                const bf16x8 vf = tr_pair(a1, a1 + 16 * 128);
                o[nt] = __builtin_amdgcn_mfma_f32_16x16x32_bf16(vf, pf.v, o[nt], 0, 0, 0);
            }
        }
        float* mg = s_mg + (qt * 64 + lane) * 18;
        if (kh == 1) {
            mg[0] = mx; mg[1] = den;
#pragma unroll
            for (int nt = 0; nt < 4; ++nt)
#pragma unroll
                for (int e = 0; e < 4; ++e) mg[2 + nt * 4 + e] = o[nt][e];
        }
        __syncthreads();
        if (kh == 0) {
            const float m2 = mg[0], d2 = mg[1];
            const float M = fmaxf(mx, m2), a1 = __expf(mx - M), a2 = __expf(m2 - M);
            const float inv = 1.0f / (den * a1 + d2 * a2);
            bf16_t* op = NQ + qtok * 512 + hd * 64 + 4 * g;
#pragma unroll
            for (int nt = 0; nt < 4; ++nt) {
                float v[4];
#pragma unroll
                for (int e = 0; e < 4; ++e) v[e] = (o[nt][e] * a1 + mg[2 + nt * 4 + e] * a2) * inv;
                u32x2 w; w.x = pk_bf16(v[0], v[1]); w.y = pk_bf16(v[2], v[3]);
                *(u32x2*)(op + nt * 16) = w;
            }
        }
    }
}

__device__ void phase_attnA_merge(const int tid, const int bid, const Params& P) {
    for (int idx0 = bid * 512 + tid; idx0 < T_TOK * 64; idx0 += gridDim.x * 512 * 4) {
        u32x4 v0[4], v1[4], v2[4]; float l0[4], l1[4], l2[4];
#pragma unroll
        for (int k = 0; k < 4; ++k) {
            const int idxr = idx0 + k * gridDim.x * 512, idx = idxr < T_TOK * 64 ? idxr : idx0, tok = idx >> 6, hd = (idx >> 3) & 7, ch = idx & 7;
            const size_t o = (size_t)tok * 512 + hd * 64 + ch * 8;
            l0[k] = P.lse[((size_t)0 * T_TOK + tok) * 8 + hd]; l1[k] = P.lse[((size_t)1 * T_TOK + tok) * 8 + hd]; l2[k] = P.lse[((size_t)2 * T_TOK + tok) * 8 + hd];
            v0[k] = *(const u32x4*)(P.part + o); v1[k] = *(const u32x4*)(P.part + U1 + o); v2[k] = *(const u32x4*)(P.part + 2 * U1 + o);
        }
#pragma unroll
        for (int k = 0; k < 4; ++k) {
            const int idxr = idx0 + k * gridDim.x * 512, idx = idxr < T_TOK * 64 ? idxr : idx0, tok = idx >> 6, hd = (idx >> 3) & 7, ch = idx & 7;
            const size_t o = (size_t)tok * 512 + hd * 64 + ch * 8;
            const float m = fmaxf(l0[k], fmaxf(l1[k], l2[k]));
            float a0 = __expf(l0[k] - m), a1 = __expf(l1[k] - m), a2 = __expf(l2[k] - m);
            const float inv = __builtin_amdgcn_rcpf(a0 + a1 + a2); a0 *= inv; a1 *= inv; a2 *= inv;
            u32x4 w;
#pragma unroll
            for (int q = 0; q < 4; ++q) w[q] = pk_bf16(a0 * bflo(v0[k][q]) + a1 * bflo(v1[k][q]) + a2 * bflo(v2[k][q]), a0 * bfhi(v0[k][q]) + a1 * bfhi(v1[k][q]) + a2 * bfhi(v2[k][q]));
            *(u32x4*)(P.big + o) = w;
        }
    }
}

constexpr int NPHASE = 1 + DEPTH * 12 + 1;
__device__ __forceinline__ void run_phase(const Params& P, int ph, unsigned char* lds) {
    int tid = threadIdx.x; asm volatile("" : "+v"(tid));
    int bid = blockIdx.x; asm volatile("" : "+s"(bid));
    if (ph == 0) { phase_mod(tid, bid, P, lds); convert_layer(tid, bid, P, 0, P.wb0, lds); return; }
    if (ph == NPHASE - 1) { phase_final_norm(tid, bid, P.out, P.final_norm); return; }
    const int l = (ph - 1) / 12, sp = (ph - 1) % 12;
    const bf16_t* wb = (l & 1) ? P.wb1 : P.wb0;
    const float* mod = P.mod + (size_t)l * 16 * NMOD;
    const float* xin = (l == 0) ? P.x : P.out;
    switch (sp) {
    case 0: phase_norm(tid, bid, xin, P.norm_g + ((size_t)l * 3 + 0) * DM, mod + 0 * DM, mod + 1 * DM, P.h); break;
    case 1: { EpiSwiglu E; E.O = P.big; run_gemm(tid, bid, lds, P.h, DM, 0, wb + W_WI1, DM, 0, T_TOK, 2 * DFF, DM, 1, E); } break;
    case 2: { EpiResid E; E.xs = xin; E.xd = P.out; E.gate = mod + 2 * DM; E.scale = 0.5f; run_gemm(tid, bid, lds, P.big, DFF, 0, wb + W_WO1, DFF, 0, T_TOK, DM, DFF, 1, E); } break;
    case 3: phase_norm(tid, bid, P.out, P.norm_g + ((size_t)l * 3 + 1) * DM, mod + 3 * DM, mod + 4 * DM, P.h);
            if (l + 1 < DEPTH) convert_layer(tid, bid, P, l + 1, ((l + 1) & 1) ? P.wb1 : P.wb0, lds);
            break;
    case 4: { EpiProj E; E.big = P.big; E.rope = P.rope; run_gemm(tid, bid, lds, P.h, DM, 0, wb + W_MIX, DM, 0, T_TOK, 5120, DM, 1, E); } break;
    case 5: phase_scan(tid, bid, P, l, lds); phase_attnA(tid, bid, P, lds); phase_attnB(tid, bid, P, l, lds); break;
    case 6: phase_attnA_merge(tid, bid, P);
            { EpiOc E; E.O = P.big + 2 * U1; E.yd = P.yd; run_gemm(tid, bid, lds, P.big + 3 * U1 + 256, 512, 0, wb + W_GUP, 256, 0, T_TOK, 512, 256, 1, E); }
            { EpiGates E; E.G0 = P.big + 4 * U1; run_gemm(tid, bid, lds, P.h, DM, 0, wb + W_G, DM, 0, T_TOK, 3072, DM, 1, E); }
            break;
    case 7: { EpiBranch E; E.Mg = P.h; E.G0 = P.big + 4 * U1; run_gemm(tid, bid, lds, P.big, 512, U1 * 2, wb + W_BR, 512, (size_t)1024 * 512 * 2, T_TOK, DM, 512, 3, E); } break;
    case 8: { EpiResid E; E.xs = P.out; E.xd = P.out; E.gate = mod + 5 * DM; E.scale = 1.0f; run_gemm(tid, bid, lds, P.h, DM, 0, wb + W_OUT, DM, 0, T_TOK, DM, DM, 1, E); } break;
    case 9: phase_norm(tid, bid, P.out, P.norm_g + ((size_t)l * 3 + 2) * DM, mod + 6 * DM, mod + 7 * DM, P.h); break;
    case 10: { EpiSwiglu E; E.O = P.big; run_gemm(tid, bid, lds, P.h, DM, 0, wb + W_WI2, DM, 0, T_TOK, 2 * DFF, DM, 1, E); } break;
    case 11: { EpiResid E; E.xs = P.out; E.xd = P.out; E.gate = mod + 8 * DM; E.scale = 0.5f; run_gemm(tid, bid, lds, P.big, DFF, 0, wb + W_WO2, DFF, 0, T_TOK, DM, DFF, 1, E); } break;
    }
}

extern __shared__ __attribute__((aligned(16))) unsigned char dyn_lds[];

#define XB_TMO      128
#define XB_XCNT(j)  (256  + 64 * (j))
#define XB_XSUB(j)  (1280 + 64 * (j))
#define XB_XGEN(j)  (2304 + 64 * (j))
#define XB_TOP      3328
#define XB_TOPGEN   3392
#define XCD_BAR_WORDS 3456
#define XB_SPIN_CAP (1u << 18)
__device__ __forceinline__ unsigned xb_ld(unsigned* p)              { return __hip_atomic_load(p, __ATOMIC_RELAXED, __HIP_MEMORY_SCOPE_AGENT); }
__device__ __forceinline__ unsigned xb_add(unsigned* p, unsigned v) { return __hip_atomic_fetch_add(p, v, __ATOMIC_RELAXED, __HIP_MEMORY_SCOPE_AGENT); }
__device__ __forceinline__ unsigned xb_xcc_id() { return (unsigned)__builtin_amdgcn_s_getreg((3 << 11) | 20) & 0xFu; }
#define XB_SPIN(cond, bar) do { unsigned _sp = 0; while (cond) { __builtin_amdgcn_s_sleep(1); \
    if ((++_sp & 255u) == 0u) { if (xb_ld(&(bar)[XB_TMO])) break; if (_sp > XB_SPIN_CAP) { atomicAdd(&(bar)[XB_TMO], 1u); break; } } } } while (0)
struct XcdBarrier { unsigned* bar; unsigned x; volatile LAS unsigned* st; };
__device__ __forceinline__ XcdBarrier xcd_barrier_post(unsigned* bar, volatile LAS unsigned* st) {
    XcdBarrier b; b.bar = bar; b.x = xb_xcc_id(); b.st = st;
    if (threadIdx.x == 0) (void)xb_add(&bar[XB_XCNT(b.x)], 1u);
    return b;
}
__device__ __forceinline__ void xcd_barrier_complete(unsigned* bar, unsigned x, unsigned& nloc, unsigned& nx) {
    const unsigned G = gridDim.x * gridDim.y * gridDim.z;
    unsigned sum, cnt, mine, sp = 0u;
    for (;;) {
        sum = 0u; cnt = 0u; mine = 0u;
#pragma unroll
        for (unsigned j = 0; j < 16; ++j) { const unsigned c = xb_ld(&bar[XB_XCNT(j)]); sum += c; cnt += (c > 0u) ? 1u : 0u; mine = (j == x) ? c : mine; }
        if (sum == G) break;
        __builtin_amdgcn_s_sleep(1);
        if ((++sp & 255u) == 0u) { if (xb_ld(&bar[XB_TMO])) break; if (sp > XB_SPIN_CAP) { atomicAdd(&bar[XB_TMO], 1u); break; } }
    }
    nloc = mine > 0u ? mine : 1u; nx = cnt > 0u ? cnt : 1u;
}
__device__ __forceinline__ void xcd_barrier(const XcdBarrier& b) {
    asm volatile("s_waitcnt vmcnt(0)" ::: "memory");
    __syncthreads();
    if (threadIdx.x == 0) {
        unsigned* bar = b.bar;
        __builtin_amdgcn_s_waitcnt(0);
        unsigned nloc = b.st[0], nx = b.st[1];
        if (nloc == 0u) { xcd_barrier_complete(bar, b.x, nloc, nx); b.st[0] = nloc; b.st[1] = nx; }
        const unsigned old = xb_add(&bar[XB_XSUB(b.x)], 1u);
        const unsigned gen = old / nloc;
        if (old + 1u == (gen + 1u) * nloc) {
            __builtin_amdgcn_fence(__ATOMIC_RELEASE, "agent");
            asm volatile("s_waitcnt vmcnt(0)" ::: "memory");
            const unsigned og = xb_add(&bar[XB_TOP], 1u);
            const unsigned tg = og / nx;
            if (og + 1u == (tg + 1u) * nx) xb_add(&bar[XB_TOPGEN], 1u);
            else XB_SPIN(xb_ld(&bar[XB_TOPGEN]) == tg, bar);
            __builtin_amdgcn_fence(__ATOMIC_ACQUIRE, "agent");
            xb_add(&bar[XB_XGEN(b.x)], 1u);
            asm volatile("s_waitcnt vmcnt(0)" ::: "memory");
        } else {
            XB_SPIN(xb_ld(&bar[XB_XGEN(b.x)]) == gen, bar);
            __builtin_amdgcn_fence(__ATOMIC_ACQUIRE, "agent");
            asm volatile("s_waitcnt vmcnt(0)" ::: "memory");
        }
    }
    __syncthreads();
}
__global__ void __launch_bounds__(512, 2) mega_kernel(Params P) {
    cg::grid_group grid = cg::this_grid();
    volatile LAS unsigned* st = (volatile LAS unsigned*)(LAS unsigned char*)(dyn_lds + LDS_BYTES - 16);
    if (threadIdx.x == 0) { st[0] = 0u; st[1] = 0u; }
    __syncthreads();
    const XcdBarrier xb = xcd_barrier_post(P.bar, st);
    for (int ph = 0; ph < NPHASE; ++ph) {
        run_phase(P, ph, dyn_lds);
        if (ph == 0) grid.sync();
        else if (ph + 1 < NPHASE) xcd_barrier(xb);
    }
}
#if MK_LAUNCHES != 1
__global__ void __launch_bounds__(512, 2) phase_kernel(Params P, int ph) { run_phase(P, ph, dyn_lds); }
#endif

extern "C" void kernel_launch(void* const* d_in, const int* in_sizes, int n_in, void* d_out, int out_size, void* d_ws, size_t ws_size, hipStream_t stream) {
    Params P{};
    P.x = (const float*)d_in[0]; P.c = (const float*)d_in[1]; P.pos = (const int*)d_in[2];
    P.ada_w = (const float*)d_in[3]; P.ada_b = (const float*)d_in[4]; P.norm_g = (const float*)d_in[5]; P.ffn_wi = (const float*)d_in[6]; P.ffn_wo = (const float*)d_in[7];
    P.w_in = (const float*)d_in[8]; P.rpb = (const float*)d_in[9]; P.mu_rkv = (const float*)d_in[10]; P.mu_w = (const float*)d_in[11]; P.mu_a = (const float*)d_in[12];
    P.w0 = (const float*)d_in[13]; P.w_up = (const float*)d_in[14]; P.a0 = (const float*)d_in[15]; P.a_up = (const float*)d_in[16]; P.g_up = (const float*)d_in[17];
    P.k_k = (const float*)d_in[18]; P.k_a = (const float*)d_in[19]; P.r_k = (const float*)d_in[20]; P.gn_w = (const float*)d_in[21]; P.gn_b = (const float*)d_in[22];
    P.w_branch = (const float*)d_in[23]; P.w_out = (const float*)d_in[24]; P.final_norm = (const float*)d_in[25];
    P.out = (float*)d_out;
    unsigned char* w = (unsigned char*)d_ws; size_t off = 0;
    auto take = [&](size_t bytes) { void* p = w + off; off += (bytes + 255) & ~(size_t)255; return p; };
    P.mod = (float*)take((size_t)4 * 16 * NMOD * 4);
    P.rope = (float*)take((size_t)T_TOK * 16 * 4);
    P.wb0 = (bf16_t*)take(W_TOTAL * 2);
    P.wb1 = (bf16_t*)take(W_TOTAL * 2);
    P.h = (bf16_t*)take((size_t)T_TOK * 1024 * 2);
    P.big = (bf16_t*)take(10 * U1 * 2);
    P.yd = (bf16_t*)take(2 * U1 * 2);
    P.part = (bf16_t*)take(3 * U1 * 2);
    P.lse = (float*)take((size_t)3 * T_TOK * 8 * 4);
    P.bar = (unsigned*)take(XCD_BAR_WORDS * 4);
    if (off > ws_size) { fprintf(stderr, "workspace too small: need %zu have %zu\n", off, ws_size); return; }
#if MK_LAUNCHES == 1
    static int grid_blocks = 0;
    if (!grid_blocks) {
        int dev = 0, cus = 0, per_cu = 0;
        hipGetDevice(&dev);
        hipDeviceGetAttribute(&cus, hipDeviceAttributeMultiprocessorCount, dev);
        hipFuncSetAttribute((const void*)mega_kernel, hipFuncAttributeMaxDynamicSharedMemorySize, LDS_BYTES);
        hipOccupancyMaxActiveBlocksPerMultiprocessor(&per_cu, mega_kernel, 512, LDS_BYTES);
        if (per_cu < 1) per_cu = 1;
        grid_blocks = cus * per_cu;
    }
    (void)hipMemsetAsync(P.bar, 0, XCD_BAR_WORDS * 4, stream);
    void* args[] = {&P};
    hipError_t e = hipLaunchCooperativeKernel((void*)mega_kernel, dim3(grid_blocks), dim3(512), args, LDS_BYTES, stream);
    if (e != hipSuccess) fprintf(stderr, "cooperative launch failed: %s (grid %d)\n", hipGetErrorString(e), grid_blocks);
#else
    static int inited = 0;
    if (!inited) { hipFuncSetAttribute((const void*)phase_kernel, hipFuncAttributeMaxDynamicSharedMemorySize, LDS_BYTES); inited = 1; }
    for (int ph = 0; ph < NPHASE; ++ph) phase_kernel<<<256, 512, LDS_BYTES, stream>>>(P, ph);
#endif
}
```

```cpp
#include <hip/hip_runtime.h>
#include <hip/hip_cooperative_groups.h>
#include <cstdio>
namespace cg = cooperative_groups;

#define LAS __attribute__((address_space(3)))
typedef unsigned short bf16_t;
typedef short bf16x8 __attribute__((ext_vector_type(8)));
typedef float f32x4 __attribute__((ext_vector_type(4)));
typedef unsigned u32x4 __attribute__((ext_vector_type(4)));
typedef unsigned u32x2 __attribute__((ext_vector_type(2)));
typedef float f32x2_ __attribute__((ext_vector_type(2)));

#ifndef MK_LAUNCHES
#define MK_LAUNCHES 1
#endif

constexpr int T_TOK = 32768, SEQ = 2048, DM = 1024, DFF = 2816, DEPTH = 4, NMOD = 9216;
constexpr size_t U1 = (size_t)T_TOK * 512;
constexpr int LDS_BYTES = 135168;

constexpr size_t W_WI1 = 0, W_WI2 = W_WI1 + 5632ull * 1024, W_WO1 = W_WI2 + 5632ull * 1024, W_WO2 = W_WO1 + 1024ull * 2816,
                 W_MIX = W_WO2 + 1024ull * 2816, W_G = W_MIX + 5120ull * 1024, W_BR = W_G + 3072ull * 1024, W_OUT = W_BR + 3ull * 1024 * 512,
                 W_GUP = W_OUT + 1024ull * 1024, W_TOTAL = W_GUP + 512ull * 256;

struct Params {
    const float *x, *c; const int* pos;
    const float *ada_w, *ada_b, *norm_g, *ffn_wi, *ffn_wo, *w_in, *rpb, *mu_rkv, *mu_w, *mu_a, *w0, *w_up, *a0, *a_up, *g_up, *k_k, *k_a, *r_k, *gn_w, *gn_b, *w_branch, *w_out, *final_norm;
    float* out;
    float* mod;
    float* rope;
    bf16_t* wb0; bf16_t* wb1;
    bf16_t* h;
    bf16_t* big;
    bf16_t* yd;
    bf16_t* part;
    float* lse;
    unsigned* bar;
};

__device__ __forceinline__ float bf2f(bf16_t v) { return __uint_as_float(((unsigned)v) << 16); }
__device__ __forceinline__ bf16_t f2bf(float f) { unsigned u = __float_as_uint(f); u += 0x7FFFu + ((u >> 16) & 1u); return (bf16_t)(u >> 16); }
typedef __bf16 bf16v2_t __attribute__((ext_vector_type(2)));
__device__ __forceinline__ unsigned pk_bf16(float lo, float hi) { const f32x2_ v = {lo, hi}; return __builtin_bit_cast(unsigned, __builtin_convertvector(v, bf16v2_t)); }
__device__ __forceinline__ float bflo(unsigned u) { return __uint_as_float(u << 16); }
__device__ __forceinline__ float bfhi(unsigned u) { return __uint_as_float(u & 0xffff0000u); }
__device__ __forceinline__ float sigmoidf_(float x) { return __builtin_amdgcn_rcpf(1.0f + __expf(-x)); }
__device__ __forceinline__ float tanhf_(float x) { return 1.0f - 2.0f * __builtin_amdgcn_rcpf(1.0f + __expf(2.0f * x)); }

namespace pg8 {
constexpr int BM = 256, BK = 64, HALF = 128, HTB = HALF * BK * 2, STAGE_BYTES = 8 * HTB, NXCD = 8, WGM = 8;
__device__ __forceinline__ int lds_byte(int r, int c) { const int st = (r >> 4) * 2 + (c >> 5), rr = r & 15, cc = c & 31, ob = rr * 64 + cc * 2; return st * 1024 + (ob ^ (((ob >> 9) & 1) << 5)); }
__device__ __forceinline__ void stage_rc(int b, int& R, int& C) { const int st = b / 1024, sb = b % 1024, swz = sb ^ (((sb >> 9) & 1) << 5); R = (st >> 1) * 16 + swz / 64; C = (st & 1) * 32 + (swz % 64) / 2; }
__device__ __forceinline__ int perm32(int rho) { const int n = rho >> 4, i = rho & 15; return 8 * (i >> 2) + 4 * n + (i & 3); }

struct Unit { int pm, pn, z; };
struct Gemm { const bf16_t* A; const bf16_t* Bt; int K, lda, ldb; size_t zA, zB; };

struct TileOrder {
    int nM, nN, nwg, G, c, nz;
    __device__ void init(int M, int N, int G_, int c_, int nz_) { nM = M / BM; nN = N / BM; nwg = nM * nN; G = G_; c = c_; nz = nz_; }
    __device__ bool next(int i, Unit& u) const {
        const int ti = i / nz; u.z = i - ti * nz;
        const long L = (long)ti * G + c; if (L >= nwg) return false;
        int wgid = (int)L; { const int q = nwg / NXCD, r = nwg % NXCD, xcd = wgid % NXCD, off = wgid / NXCD; wgid = (xcd < r ? xcd * (q + 1) : r * (q + 1) + (xcd - r) * q) + off; }
        const int nig = WGM * nN, gid = wgid / nig, fm = gid * WGM, gsz = (nM - fm) < WGM ? (nM - fm) : WGM;
        u.pm = fm + ((wgid % nig) % gsz); u.pn = (wgid % nig) / gsz; return true;
    }
};

template <class Epi>
__device__ __forceinline__ void gemm_phase(LAS unsigned char* lds, const Gemm g, const TileOrder& S, const Epi& E, const int tid) {
    const int wid = __builtin_amdgcn_readfirstlane(tid >> 6), lane = tid & 63, wr = wid >> 2, wc = wid & 3, fr = lane & 15, fq = lane >> 4;
    const int K = g.K, nt = K / BK;
    unsigned voffA[2], voffB[2];
#pragma unroll
    for (int i = 0; i < 2; ++i) { int R, C; stage_rc(tid * 16 + i * 8192, R, C); const int Rb = Epi::PERM ? ((R & ~31) + perm32(R & 31)) : R;
        voffA[i] = (unsigned)(R * g.lda + C) * 2u; voffB[i] = (unsigned)(Rb * g.ldb + C) * 2u; }
    const size_t kstep = (size_t)(BK * 2);
    const size_t hstepA = (size_t)HALF * g.lda * 2, hstepB = (size_t)HALF * g.ldb * 2;
    const size_t tstepA = 2 * hstepA, tstepB = 2 * hstepB;
    const unsigned ldsw = (unsigned)wid * 1024u;
    const int aoff = lds_byte(wr * 64 + fr, fq * 8), boff = lds_byte(wc * 32 + fr, fq * 8);
#define PG8_SA(b, h) (((b) * 2 + (h)) * HTB)
#define PG8_SB(b, h) ((4 + (b) * 2 + (h)) * HTB)
#define PG8_STAGE(bufoff, gbase, voff) do { _Pragma("unroll") for (int _i = 0; _i < 2; ++_i) \
        __builtin_amdgcn_global_load_lds((const unsigned*)((const char*)(gbase) + (voff)[_i]), (LAS unsigned*)(lds + (bufoff) + ldsw + _i * 8192), 16, 0, 0); } while (0)
#define PG8_LDA(dst, b, h) do { _Pragma("unroll") for (int m = 0; m < 4; ++m) _Pragma("unroll") for (int k = 0; k < 2; ++k) dst[m][k] = *(const LAS bf16x8*)(lds + PG8_SA(b, h) + aoff + m * 2048 + k * 1024); } while (0)
#define PG8_LDB(dst, b, h) do { _Pragma("unroll") for (int n = 0; n < 2; ++n) _Pragma("unroll") for (int k = 0; k < 2; ++k) dst[n][k] = *(const LAS bf16x8*)(lds + PG8_SB(b, h) + boff + n * 2048 + k * 1024); } while (0)
#define PG8_MMA(ai, bj, At, Bt) do { __builtin_amdgcn_s_setprio(1); _Pragma("unroll") for (int m = 0; m < 4; ++m) _Pragma("unroll") for (int n = 0; n < 2; ++n) _Pragma("unroll") for (int k = 0; k < 2; ++k) \
        acc[ai][bj][m][n] = __builtin_amdgcn_mfma_f32_16x16x32_bf16(Bt[n][k], At[m][k], acc[ai][bj][m][n], 0, 0, 0); __builtin_amdgcn_s_setprio(0); } while (0)
#define PG8_WAIT_V(n) asm volatile("s_waitcnt vmcnt(" #n ")" ::: "memory")
#define PG8_WAIT_L(n) asm volatile("s_waitcnt lgkmcnt(" #n ")" ::: "memory")
#define PG8_BAR __builtin_amdgcn_s_barrier()
#define PG8_SCHED __builtin_amdgcn_sched_barrier(0)
    Unit cur, nxt; int ui = 0;
    if (!S.next(0, cur)) return;
    f32x4 acc[2][2][4][2];
#pragma unroll
    for (int a = 0; a < 2; ++a)
#pragma unroll
        for (int b = 0; b < 2; ++b)
#pragma unroll
            for (int m = 0; m < 4; ++m)
#pragma unroll
                for (int n = 0; n < 2; ++n) acc[a][b][m][n] = (f32x4){0.f, 0.f, 0.f, 0.f};
    bf16x8 At[4][2], B0[2][2], B1[2][2];
    const char* cA = (const char*)g.A + (size_t)cur.z * g.zA + (size_t)cur.pm * tstepA; const char* cB = (const char*)g.Bt + (size_t)cur.z * g.zB + (size_t)cur.pn * tstepB;
    PG8_STAGE(PG8_SB(0, 0), cB, voffB); PG8_STAGE(PG8_SA(0, 0), cA, voffA); PG8_STAGE(PG8_SB(0, 1), cB + hstepB, voffB); PG8_STAGE(PG8_SA(0, 1), cA + hstepA, voffA);
    if (wr == 1) PG8_BAR;
    PG8_WAIT_V(4); PG8_BAR;
    PG8_STAGE(PG8_SB(1, 0), cB + kstep, voffB); PG8_STAGE(PG8_SA(1, 0), cA + kstep, voffA); PG8_STAGE(PG8_SB(1, 1), cB + hstepB + kstep, voffB);
    PG8_WAIT_V(6); PG8_BAR;
    for (;;) {
        const bool has_next = S.next(ui + 1, nxt);
        const char* nA = has_next ? (const char*)g.A + (size_t)nxt.z * g.zA + (size_t)nxt.pm * tstepA : cA; const char* nB = has_next ? (const char*)g.Bt + (size_t)nxt.z * g.zB + (size_t)nxt.pn * tstepB : cB;
#pragma nounroll
        for (int t = 0; t < nt; t += 2) {
            const bool last = (t == nt - 2);
            const char* a1 = cA + (size_t)(t + 1) * kstep;
            const char* a2 = last ? nA : cA + (size_t)(t + 2) * kstep; const char* b2 = last ? nB : cB + (size_t)(t + 2) * kstep;
            const char* a3 = a2 + kstep; const char* b3 = b2 + kstep;
            PG8_LDB(B0, 0, 0); PG8_SCHED; PG8_LDA(At, 0, 0); PG8_STAGE(PG8_SA(1, 1), a1 + hstepA, voffA);
            PG8_WAIT_L(8); PG8_BAR; PG8_WAIT_L(0); PG8_MMA(0, 0, At, B0); PG8_BAR; PG8_SCHED;
            PG8_LDB(B1, 0, 1); PG8_STAGE(PG8_SB(0, 0), b2, voffB);
            PG8_BAR; PG8_WAIT_L(0); PG8_MMA(0, 1, At, B1); PG8_BAR;
            PG8_LDA(At, 0, 1); PG8_STAGE(PG8_SA(0, 0), a2, voffA);
            PG8_BAR; PG8_WAIT_L(0); PG8_MMA(1, 0, At, B0); PG8_BAR; PG8_SCHED;
            PG8_STAGE(PG8_SB(0, 1), b2 + hstepB, voffB);
            PG8_WAIT_V(6); PG8_BAR; PG8_MMA(1, 1, At, B1); PG8_BAR;
            PG8_LDB(B0, 1, 0); PG8_SCHED; PG8_LDA(At, 1, 0); PG8_STAGE(PG8_SA(0, 1), a2 + hstepA, voffA);
            PG8_WAIT_L(8); PG8_BAR; PG8_WAIT_L(0); PG8_MMA(0, 0, At, B0); PG8_BAR; PG8_SCHED;
            PG8_LDB(B1, 1, 1); PG8_STAGE(PG8_SB(1, 0), b3, voffB);
            PG8_BAR; PG8_WAIT_L(0); PG8_MMA(0, 1, At, B1); PG8_BAR;
            PG8_LDA(At, 1, 1); PG8_STAGE(PG8_SA(1, 0), a3, voffA);
            PG8_BAR; PG8_WAIT_L(0); PG8_MMA(1, 0, At, B0); PG8_BAR; PG8_SCHED;
            PG8_STAGE(PG8_SB(1, 1), b3 + hstepB, voffB);
            PG8_WAIT_V(6); PG8_BAR; PG8_MMA(1, 1, At, B1); PG8_BAR;
        }
        E(acc, cur, wr, wc, fr, fq);
        if (!has_next) break;
#pragma unroll
        for (int a = 0; a < 2; ++a)
#pragma unroll
            for (int b = 0; b < 2; ++b)
#pragma unroll
                for (int m = 0; m < 4; ++m)
#pragma unroll
                    for (int n = 0; n < 2; ++n) acc[a][b][m][n] = (f32x4){0.f, 0.f, 0.f, 0.f};
        cur = nxt; cA = nA; cB = nB; ++ui;
    }
    PG8_WAIT_V(0);
    if (wr == 0) PG8_BAR;
    PG8_BAR;
#undef PG8_SA
#undef PG8_SB
#undef PG8_STAGE
#undef PG8_LDA
#undef PG8_LDB
#undef PG8_MMA
#undef PG8_WAIT_V
#undef PG8_WAIT_L
#undef PG8_BAR
#undef PG8_SCHED
}
}
using pg8::Unit;

typedef f32x4 Acc[2][2][4][2];

struct EpiSwiglu {
    static constexpr bool PERM = true;
    bf16_t* O;
    __device__ __forceinline__ void operator()(const Acc& acc, const Unit& u, int wr, int wc, int fr, int fq) const {
        const int row0 = u.pm * 256 + wr * 64 + fr, col0 = u.pn * 128 + wc * 32 + 8 * fq;
#pragma unroll
        for (int ai = 0; ai < 2; ++ai)
#pragma unroll
            for (int m = 0; m < 4; ++m) {
                bf16_t* rowp = O + (size_t)(row0 + ai * 128 + m * 16) * DFF + col0;
                float r[8];
#pragma unroll
                for (int n = 0; n < 2; ++n)
#pragma unroll
                    for (int j = 0; j < 4; ++j) { const float gt = acc[ai][0][m][n][j], up = acc[ai][1][m][n][j]; r[n * 4 + j] = gt * sigmoidf_(gt) * up; }
                u32x4 w; w.x = pk_bf16(r[0], r[1]); w.y = pk_bf16(r[2], r[3]); w.z = pk_bf16(r[4], r[5]); w.w = pk_bf16(r[6], r[7]);
                *(u32x4*)rowp = w;
            }
    }
};
struct EpiResid {
    static constexpr bool PERM = false;
    const float* xs; float* xd; const float* gate; float scale;
    __device__ __forceinline__ void operator()(const Acc& acc, const Unit& u, int wr, int wc, int fr, int fq) const {
        const int row0 = u.pm * 256 + wr * 64 + fr, col0 = u.pn * 256 + wc * 32 + 4 * fq, b = u.pm >> 3;
        f32x4 gv[2][2];
#pragma unroll
        for (int bj = 0; bj < 2; ++bj)
#pragma unroll
            for (int n = 0; n < 2; ++n) gv[bj][n] = *(const f32x4*)(gate + (size_t)b * NMOD + col0 + bj * 128 + n * 16) * scale;
#pragma unroll
        for (int am = 0; am < 4; ++am) {
            const int ai = am >> 1, m0 = (am & 1) * 2;
            f32x4 xv[2][2][2];
#pragma unroll
            for (int mm = 0; mm < 2; ++mm) {
                const size_t ro = (size_t)(row0 + ai * 128 + (m0 + mm) * 16) * DM + col0;
#pragma unroll
                for (int bj = 0; bj < 2; ++bj)
#pragma unroll
                    for (int n = 0; n < 2; ++n) xv[mm][bj][n] = *(const f32x4*)(xs + ro + bj * 128 + n * 16);
            }
#pragma unroll
            for (int mm = 0; mm < 2; ++mm) {
                const size_t ro = (size_t)(row0 + ai * 128 + (m0 + mm) * 16) * DM + col0;
#pragma unroll
                for (int bj = 0; bj < 2; ++bj)
#pragma unroll
                    for (int n = 0; n < 2; ++n) *(f32x4*)(xd + ro + bj * 128 + n * 16) = xv[mm][bj][n] + gv[bj][n] * acc[ai][bj][m0 + mm][n];
            }
        }
    }
};
struct EpiProj {
    static constexpr bool PERM = true;
    bf16_t* big; const float* rope;
    __device__ __forceinline__ void operator()(const Acc& acc, const Unit& u, int wr, int wc, int fr, int fq) const {
        const int bi = u.pn >> 1, colt = (u.pn & 1) * 256;
        bf16_t* base = big + (size_t)bi * U1;
        const int row0 = u.pm * 256 + wr * 64 + fr, col0 = colt + wc * 32 + 8 * fq;
        const bool rot = (bi == 0 || bi == 4) && ((wc & 1) == 0);
        const bool sg = (bi == 3) && (colt == 256);
#pragma unroll
        for (int am = 0; am < 4; ++am) {
            const int ai = am >> 1, m0 = (am & 1) * 2;
            f32x4 rc[2][4];
#pragma unroll
            for (int mm = 0; mm < 2; ++mm)
#pragma unroll
                for (int q = 0; q < 4; ++q) rc[mm][q] = (f32x4){0.f, 0.f, 0.f, 0.f};
            if (rot && fq < 2) {
#pragma unroll
                for (int mm = 0; mm < 2; ++mm) {
                    const float* rp = rope + (size_t)(row0 + ai * 128 + (m0 + mm) * 16) * 16;
#pragma unroll
                    for (int q = 0; q < 4; ++q) rc[mm][q] = *(const f32x4*)(rp + 4 * q);
                }
            }
#pragma unroll
            for (int mm = 0; mm < 2; ++mm) {
                const int m = m0 + mm;
                const int row = row0 + ai * 128 + m * 16;
                bf16_t* rowp = base + (size_t)row * 512 + col0;
#pragma unroll
                for (int bj = 0; bj < 2; ++bj) {
                    float r[8];
#pragma unroll
                    for (int n = 0; n < 2; ++n)
#pragma unroll
                        for (int j = 0; j < 4; ++j) r[n * 4 + j] = acc[ai][bj][m][n][j];
                    if (rot) {
                        float pr[8];
#pragma unroll
                        for (int j = 0; j < 8; ++j) pr[j] = __shfl_xor(r[j], 16);
                        if (fq < 2) {
                            const float sgn = fq == 0 ? -1.0f : 1.0f;
#pragma unroll
                            for (int j = 0; j < 4; ++j) { r[j] = r[j] * rc[mm][0][j] + sgn * pr[j] * rc[mm][2][j]; r[4 + j] = r[4 + j] * rc[mm][1][j] + sgn * pr[4 + j] * rc[mm][3][j]; }
                        }
                    }
                    if (sg) {
#pragma unroll
                        for (int j = 0; j < 8; ++j) r[j] = sigmoidf_(r[j]);
                    }
                    u32x4 w; w.x = pk_bf16(r[0], r[1]); w.y = pk_bf16(r[2], r[3]); w.z = pk_bf16(r[4], r[5]); w.w = pk_bf16(r[6], r[7]);
                    *(u32x4*)(rowp + bj * 128) = w;
                }
            }
        }
    }
};
struct EpiGates {
    static constexpr bool PERM = true;
    bf16_t* G0;
    __device__ __forceinline__ void operator()(const Acc& acc, const Unit& u, int wr, int wc, int fr, int fq) const {
        bf16_t* base = G0 + (size_t)(u.pn >> 2) * 2 * U1;
        const int row0 = u.pm * 256 + wr * 64 + fr, col0 = (u.pn & 3) * 256 + wc * 32 + 8 * fq;
#pragma unroll
        for (int ai = 0; ai < 2; ++ai)
#pragma unroll
            for (int m = 0; m < 4; ++m) {
                bf16_t* rowp = base + (size_t)(row0 + ai * 128 + m * 16) * 1024 + col0;
#pragma unroll
                for (int bj = 0; bj < 2; ++bj) {
                    float r[8];
#pragma unroll
                    for (int n = 0; n < 2; ++n)
#pragma unroll
                        for (int j = 0; j < 4; ++j) r[n * 4 + j] = sigmoidf_(acc[ai][bj][m][n][j]);
                    u32x4 w; w.x = pk_bf16(r[0], r[1]); w.y = pk_bf16(r[2], r[3]); w.z = pk_bf16(r[4], r[5]); w.w = pk_bf16(r[6], r[7]);
                    *(u32x4*)(rowp + bj * 128) = w;
                }
            }
    }
};
struct EpiBranch {
    static constexpr bool PERM = true;
    bf16_t* Mg; const bf16_t* G0;
    __device__ __forceinline__ void operator()(const Acc& acc, const Unit& u, int wr, int wc, int fr, int fq) const {
        const bf16_t* gate = G0 + (size_t)u.z * 2 * U1;
        const int row0 = u.pm * 256 + wr * 64 + fr, col0 = u.pn * 256 + wc * 32 + 8 * fq;
#pragma unroll
        for (int ai = 0; ai < 2; ++ai) {
            u32x4 gv[4][2], ov[4][2];
#pragma unroll
            for (int m = 0; m < 4; ++m) {
                const size_t ro = (size_t)(row0 + ai * 128 + m * 16) * 1024 + col0;
#pragma unroll
                for (int bj = 0; bj < 2; ++bj) {
                    gv[m][bj] = *(const u32x4*)(gate + ro + bj * 128);
                    ov[m][bj] = (u32x4){0u, 0u, 0u, 0u};
                    if (u.z != 0) ov[m][bj] = *(const u32x4*)(Mg + ro + bj * 128);
                }
            }
#pragma unroll
            for (int m = 0; m < 4; ++m) {
                const size_t ro = (size_t)(row0 + ai * 128 + m * 16) * 1024 + col0;
#pragma unroll
                for (int bj = 0; bj < 2; ++bj) {
                    float r[8];
#pragma unroll
                    for (int q = 0; q < 4; ++q) {
                        const int n = q >> 1, j = (q & 1) * 2;
                        r[2 * q] = bflo(ov[m][bj][q]) + bflo(gv[m][bj][q]) * acc[ai][bj][m][n][j];
                        r[2 * q + 1] = bfhi(ov[m][bj][q]) + bfhi(gv[m][bj][q]) * acc[ai][bj][m][n][j + 1];
                    }
                    u32x4 w; w.x = pk_bf16(r[0], r[1]); w.y = pk_bf16(r[2], r[3]); w.z = pk_bf16(r[4], r[5]); w.w = pk_bf16(r[6], r[7]);
                    *(u32x4*)(Mg + ro + bj * 128) = w;
                }
            }
        }
    }
};
struct EpiOc {
    static constexpr bool PERM = true;
    bf16_t* O; const bf16_t* yd;
    __device__ __forceinline__ void operator()(const Acc& acc, const Unit& u, int wr, int wc, int fr, int fq) const {
        const int row0 = u.pm * 256 + wr * 64 + fr, col0 = u.pn * 256 + wc * 32 + 8 * fq;
#pragma unroll
        for (int ai = 0; ai < 2; ++ai) {
            u32x4 y0[4][2], y1[4][2];
#pragma unroll
            for (int m = 0; m < 4; ++m) {
                const size_t ro = (size_t)(row0 + ai * 128 + m * 16) * 512 + col0;
#pragma unroll
                for (int bj = 0; bj < 2; ++bj) { y0[m][bj] = *(const u32x4*)(yd + ro + bj * 128); y1[m][bj] = *(const u32x4*)(yd + U1 + ro + bj * 128); }
            }
#pragma unroll
            for (int m = 0; m < 4; ++m) {
                const size_t ro = (size_t)(row0 + ai * 128 + m * 16) * 512 + col0;
#pragma unroll
                for (int bj = 0; bj < 2; ++bj) {
                    float r[8];
#pragma unroll
                    for (int q = 0; q < 4; ++q) {
                        const int n = q >> 1, j = (q & 1) * 2;
                        r[2 * q] = (bflo(y0[m][bj][q]) + bflo(y1[m][bj][q])) * acc[ai][bj][m][n][j];
                        r[2 * q + 1] = (bfhi(y0[m][bj][q]) + bfhi(y1[m][bj][q])) * acc[ai][bj][m][n][j + 1];
                    }
                    u32x4 w; w.x = pk_bf16(r[0], r[1]); w.y = pk_bf16(r[2], r[3]); w.z = pk_bf16(r[4], r[5]); w.w = pk_bf16(r[6], r[7]);
                    *(u32x4*)(O + ro + bj * 128) = w;
                }
            }
        }
    }
};

template <class Epi>
__device__ __forceinline__ void run_gemm(int tid_, int bid, unsigned char* lds, const bf16_t* A, int lda, size_t zA, const bf16_t* Bt, int ldb, size_t zB, int M, int N, int K, int nz, const Epi& E) {
    pg8::Gemm g; g.A = A; g.Bt = Bt; g.K = K; g.lda = lda; g.ldb = ldb; g.zA = zA; g.zB = zB;
    int tid = tid_; asm volatile("" : "+v"(tid));
    pg8::TileOrder S; S.init(M, N, (int)gridDim.x, bid, nz);
    pg8::gemm_phase<Epi>((LAS unsigned char*)lds, g, S, E, tid);
}

__device__ __forceinline__ int map_col(int id, int n) {
    if (id <= 1) { const int blk = n >> 8, w = n & 255; return (w >> 7) * DFF + blk * 128 + (w & 127); }
    if (id == 4) {
        const int bi = n >> 9, w = n & 511;
        int off;
        switch (bi) { case 0: off = 0; break; case 1: off = 1536; break; case 2: off = 3072; break; case 3: off = 4608; break; case 4: off = 512; break;
                      case 5: off = 1024; break; case 6: off = 2048; break; case 7: off = 2560; break; case 8: off = 3584; break; default: off = 4096; break; }
        if (bi == 3 && w >= 384) return -1;
        return off + w;
    }
    if (id == 5) return 4992 + n;
    return n;
}
__device__ void convert_layer(const int tid, const int bid, const Params& P, int l, bf16_t* wb, unsigned char* lds_raw) {
    float* tile = (float*)lds_raw;
    for (int it = bid; it < 3472; it += gridDim.x) {
        int id, t = it; const float* src; int ld, K, N; bf16_t* dst;
        if (t < 704) { id = 0; src = P.ffn_wi + ((size_t)l * 2 + 0) * 1024 * 5632; ld = 5632; K = 1024; N = 5632; dst = wb + W_WI1; }
        else if ((t -= 704) < 704) { id = 1; src = P.ffn_wi + ((size_t)l * 2 + 1) * 1024 * 5632; ld = 5632; K = 1024; N = 5632; dst = wb + W_WI2; }
        else if ((t -= 704) < 352) { id = 2; src = P.ffn_wo + ((size_t)l * 2 + 0) * 2816 * 1024; ld = 1024; K = 2816; N = 1024; dst = wb + W_WO1; }
        else if ((t -= 352) < 352) { id = 3; src = P.ffn_wo + ((size_t)l * 2 + 1) * 2816 * 1024; ld = 1024; K = 2816; N = 1024; dst = wb + W_WO2; }
        else if ((t -= 352) < 640) { id = 4; src = P.w_in + (size_t)l * 1024 * 8064; ld = 8064; K = 1024; N = 5120; dst = wb + W_MIX; }
        else if ((t -= 640) < 384) { id = 5; src = P.w_in + (size_t)l * 1024 * 8064; ld = 8064; K = 1024; N = 3072; dst = wb + W_G; }
        else if ((t -= 384) < 192) { id = 6; const int b = t / 64; t -= b * 64; src = P.w_branch + ((size_t)l * 3 + b) * 512 * 1024; ld = 1024; K = 512; N = 1024; dst = wb + W_BR + (size_t)b * 1024 * 512; }
        else if ((t -= 192) < 128) { id = 9; src = P.w_out + (size_t)l * 1024 * 1024; ld = 1024; K = 1024; N = 1024; dst = wb + W_OUT; }
        else { t -= 128; id = 10; src = P.g_up + (size_t)l * 128 * 512; ld = 512; K = 256; N = 512; dst = wb + W_GUP; }
        (void)N;
        const int nk = K >> 7, kt = t % nk, ntile = t / nk, k0 = kt * 128, n0 = ntile * 64;
        const int cbase = map_col(id, n0);
        const bool zero = (cbase < 0) || (id == 10 && k0 >= 128);
        const int lane = tid & 63, w = tid >> 6;
        __syncthreads();
        float v[16];
#pragma unroll
        for (int i = 0; i < 16; ++i) { const int k = w * 16 + i; v[i] = zero ? 0.f : src[(size_t)(k0 + k) * ld + cbase + lane]; }
#pragma unroll
        for (int i = 0; i < 16; ++i) tile[(w * 16 + i) * 65 + lane] = v[i];
        __syncthreads();
        const int n = tid >> 3, ks = (tid & 7) * 16;
        float r[16];
#pragma unroll
        for (int e2 = 0; e2 < 16; ++e2) r[e2] = tile[(ks + e2) * 65 + n];
        u32x4 w0, w1;
        w0.x = pk_bf16(r[0], r[1]); w0.y = pk_bf16(r[2], r[3]); w0.z = pk_bf16(r[4], r[5]); w0.w = pk_bf16(r[6], r[7]);
        w1.x = pk_bf16(r[8], r[9]); w1.y = pk_bf16(r[10], r[11]); w1.z = pk_bf16(r[12], r[13]); w1.w = pk_bf16(r[14], r[15]);
        bf16_t* dp = dst + (size_t)(n0 + n) * K + k0 + ks;
        *(u32x4*)dp = w0; *(u32x4*)(dp + 8) = w1;
    }
    __syncthreads();
}

__device__ void phase_mod(const int tid, const int bid, const Params& P, unsigned char* lds_raw) {
    float* cs = (float*)lds_raw;
    float* part = cs + 16384;
    for (int i = tid; i < 16384; i += 512) { const int b = i & 15, k = i >> 4; const float v = P.c[b * 1024 + k]; cs[k * 16 + b] = v * sigmoidf_(v); }
    __syncthreads();
    for (int item = bid; item < 288; item += gridDim.x) {
        const int l = item / 72, cb = item % 72, cl = tid & 127, kq = tid >> 7, col = cb * 128 + cl;
        float acc[16];
#pragma unroll
        for (int b = 0; b < 16; ++b) acc[b] = 0.f;
        const float* wp = P.ada_w + ((size_t)l * 1024 + kq * 256) * NMOD + col;
#pragma unroll 16
        for (int k = 0; k < 256; ++k) {
            const float w = wp[(size_t)k * NMOD];
            const f32x4* cv = (const f32x4*)(cs + (kq * 256 + k) * 16);
#pragma unroll
            for (int q = 0; q < 4; ++q) { const f32x4 c4 = cv[q]; acc[q * 4 + 0] += w * c4[0]; acc[q * 4 + 1] += w * c4[1]; acc[q * 4 + 2] += w * c4[2]; acc[q * 4 + 3] += w * c4[3]; }
        }
#pragma unroll
        for (int b = 0; b < 16; ++b) part[(kq * 16 + b) * 128 + cl] = acc[b];
        __syncthreads();
        for (int o = tid; o < 2048; o += 512) {
            const int b = o >> 7, cc = o & 127;
            const float s = part[(0 * 16 + b) * 128 + cc] + part[(1 * 16 + b) * 128 + cc] + part[(2 * 16 + b) * 128 + cc] + part[(3 * 16 + b) * 128 + cc] + P.ada_b[(size_t)l * NMOD + cb * 128 + cc];
            P.mod[((size_t)l * 16 + b) * NMOD + cb * 128 + cc] = s;
        }
        __syncthreads();
    }
    for (int i = bid * 512 + tid; i < T_TOK * 8; i += gridDim.x * 512) {
        const int t = i >> 3, f = i & 7;
        double invf;
        switch (f) { case 0: invf = 1.0; break; case 1: invf = 0.19392274474868576; break; case 2: invf = 0.03760603093086393; break; case 3: invf = 0.007292664737217109; break;
                     case 4: invf = 0.001414213562373095; break; case 5: invf = 0.0002742481756762073; break; case 6: invf = 5.318295896944988e-05; break; default: invf = 1.031338537721246e-05; break; }
        double rev = (double)P.pos[t] * invf * 0.15915494309189535;
        rev -= floor(rev);
        const float fr = (float)rev;
        P.rope[(size_t)t * 16 + f] = __builtin_amdgcn_cosf(fr);
        P.rope[(size_t)t * 16 + 8 + f] = __builtin_amdgcn_sinf(fr);
    }
}

__device__ void phase_norm(const int tid, const int bid, const float* xs, const float* g, const float* shift, const float* scale, bf16_t* h) {
    const int lane = tid & 63, wid = tid >> 6;
    for (int row = (bid * 8 + wid) * 4; row < T_TOK; row += gridDim.x * 32) {
        f32x4 v[4][4]; float ss[4] = {0.f, 0.f, 0.f, 0.f};
#pragma unroll
        for (int rr = 0; rr < 4; ++rr)
#pragma unroll
            for (int j = 0; j < 4; ++j) v[rr][j] = *(const f32x4*)(xs + (size_t)(row + rr) * DM + j * 256 + lane * 4);
        const int b = row >> 11;
        f32x4 gg[4], sc[4], sh[4];
#pragma unroll
        for (int j = 0; j < 4; ++j) {
            const int col = j * 256 + lane * 4;
            gg[j] = *(const f32x4*)(g + col); sc[j] = *(const f32x4*)(scale + (size_t)b * NMOD + col); sh[j] = *(const f32x4*)(shift + (size_t)b * NMOD + col);
        }
#pragma unroll
        for (int rr = 0; rr < 4; ++rr)
#pragma unroll
            for (int j = 0; j < 4; ++j) ss[rr] += v[rr][j][0] * v[rr][j][0] + v[rr][j][1] * v[rr][j][1] + v[rr][j][2] * v[rr][j][2] + v[rr][j][3] * v[rr][j][3];
#pragma unroll
        for (int o = 32; o >= 1; o >>= 1) {
#pragma unroll
            for (int rr = 0; rr < 4; ++rr) ss[rr] += __shfl_xor(ss[rr], o);
        }
#pragma unroll
        for (int rr = 0; rr < 4; ++rr) {
            const float rstd = rsqrtf(ss[rr] * (1.0f / 1024.0f) + 1e-6f);
#pragma unroll
            for (int j = 0; j < 4; ++j) {
                const int col = j * 256 + lane * 4;
                float r[4];
#pragma unroll
                for (int q = 0; q < 4; ++q) r[q] = v[rr][j][q] * rstd * gg[j][q] * (1.0f + sc[j][q]) + sh[j][q];
                u32x2 w; w.x = pk_bf16(r[0], r[1]); w.y = pk_bf16(r[2], r[3]);
                *(u32x2*)(h + (size_t)(row + rr) * DM + col) = w;
            }
        }
    }
}
__device__ void phase_final_norm(const int tid, const int bid, float* x, const float* g) {
    const int lane = tid & 63, wid = tid >> 6;
    for (int row = (bid * 8 + wid) * 4; row < T_TOK; row += gridDim.x * 32) {
        f32x4 v[4][4]; float ss[4] = {0.f, 0.f, 0.f, 0.f};
#pragma unroll
        for (int rr = 0; rr < 4; ++rr)
#pragma unroll
            for (int j = 0; j < 4; ++j) v[rr][j] = *(const f32x4*)(x + (size_t)(row + rr) * DM + j * 256 + lane * 4);
#pragma unroll
        for (int rr = 0; rr < 4; ++rr)
#pragma unroll
            for (int j = 0; j < 4; ++j) ss[rr] += v[rr][j][0] * v[rr][j][0] + v[rr][j][1] * v[rr][j][1] + v[rr][j][2] * v[rr][j][2] + v[rr][j][3] * v[rr][j][3];
#pragma unroll
        for (int o = 32; o >= 1; o >>= 1) {
#pragma unroll
            for (int rr = 0; rr < 4; ++rr) ss[rr] += __shfl_xor(ss[rr], o);
        }
#pragma unroll
        for (int rr = 0; rr < 4; ++rr) {
            const float rstd = rsqrtf(ss[rr] * (1.0f / 1024.0f) + 1e-6f);
#pragma unroll
            for (int j = 0; j < 4; ++j) { const f32x4 gg = *(const f32x4*)(g + j * 256 + lane * 4); *(f32x4*)(x + (size_t)(row + rr) * DM + j * 256 + lane * 4) = v[rr][j] * rstd * gg; }
        }
    }
}


typedef float f32x2 __attribute__((ext_vector_type(2)));
__device__ __forceinline__ void red16x2(float& a, float& b) {
    asm volatile("s_nop 1\n\t"
                 "v_add_f32_dpp %0, %0, %0 quad_perm:[1,0,3,2] row_mask:0xf bank_mask:0xf\n\t"
                 "v_add_f32_dpp %1, %1, %1 quad_perm:[1,0,3,2] row_mask:0xf bank_mask:0xf\n\t"
                 "s_nop 0\n\t"
                 "v_add_f32_dpp %0, %0, %0 quad_perm:[2,3,0,1] row_mask:0xf bank_mask:0xf\n\t"
                 "v_add_f32_dpp %1, %1, %1 quad_perm:[2,3,0,1] row_mask:0xf bank_mask:0xf\n\t"
                 "s_nop 0\n\t"
                 "v_add_f32_dpp %0, %0, %0 row_half_mirror row_mask:0xf bank_mask:0xf\n\t"
                 "v_add_f32_dpp %1, %1, %1 row_half_mirror row_mask:0xf bank_mask:0xf\n\t"
                 "s_nop 0\n\t"
                 "v_add_f32_dpp %0, %0, %0 row_mirror row_mask:0xf bank_mask:0xf\n\t"
                 "v_add_f32_dpp %1, %1, %1 row_mirror row_mask:0xf bank_mask:0xf\n\t"
                 "s_nop 0"
                 : "+v"(a), "+v"(b));
}
__device__ __forceinline__ void red8(float& a) {
    asm volatile("s_nop 1\n\t"
                 "v_add_f32_dpp %0, %0, %0 quad_perm:[1,0,3,2] row_mask:0xf bank_mask:0xf\n\t"
                 "s_nop 1\n\t"
                 "v_add_f32_dpp %0, %0, %0 quad_perm:[2,3,0,1] row_mask:0xf bank_mask:0xf\n\t"
                 "s_nop 1\n\t"
                 "v_add_f32_dpp %0, %0, %0 row_half_mirror row_mask:0xf bank_mask:0xf\n\t"
                 "s_nop 0"
                 : "+v"(a));
}
__device__ __forceinline__ void red8x4(float& a, float& b, float& c, float& d) {
    asm volatile("s_nop 1\n\t"
                 "v_add_f32_dpp %0, %0, %0 quad_perm:[1,0,3,2] row_mask:0xf bank_mask:0xf\n\t"
                 "v_add_f32_dpp %1, %1, %1 quad_perm:[1,0,3,2] row_mask:0xf bank_mask:0xf\n\t"
                 "v_add_f32_dpp %2, %2, %2 quad_perm:[1,0,3,2] row_mask:0xf bank_mask:0xf\n\t"
                 "v_add_f32_dpp %3, %3, %3 quad_perm:[1,0,3,2] row_mask:0xf bank_mask:0xf\n\t"
                 "v_add_f32_dpp %0, %0, %0 quad_perm:[2,3,0,1] row_mask:0xf bank_mask:0xf\n\t"
                 "v_add_f32_dpp %1, %1, %1 quad_perm:[2,3,0,1] row_mask:0xf bank_mask:0xf\n\t"
                 "v_add_f32_dpp %2, %2, %2 quad_perm:[2,3,0,1] row_mask:0xf bank_mask:0xf\n\t"
                 "v_add_f32_dpp %3, %3, %3 quad_perm:[2,3,0,1] row_mask:0xf bank_mask:0xf\n\t"
                 "v_add_f32_dpp %0, %0, %0 row_half_mirror row_mask:0xf bank_mask:0xf\n\t"
                 "v_add_f32_dpp %1, %1, %1 row_half_mirror row_mask:0xf bank_mask:0xf\n\t"
                 "v_add_f32_dpp %2, %2, %2 row_half_mirror row_mask:0xf bank_mask:0xf\n\t"
                 "v_add_f32_dpp %3, %3, %3 row_half_mirror row_mask:0xf bank_mask:0xf\n\t"
                 "s_nop 1"
                 : "+v"(a), "+v"(b), "+v"(c), "+v"(d));
}
constexpr int CH = 32;
__device__ __forceinline__ int sw_off(int row, int col) { return row * 128 + ((((col >> 3) ^ (row & 7))) << 4) + (col & 7) * 2; }
__device__ __forceinline__ bf16x8 sw_frag(const unsigned char* base, int row, int ks, int g4) { return *(const bf16x8*)(base + row * 128 + (((ks * 4 + g4) ^ (row & 7)) << 4)); }
__device__ __forceinline__ bf16_t bf1(float f) { return (bf16_t)(pk_bf16(f, 0.f) & 0xffffu); }
typedef short s16x4s __attribute__((ext_vector_type(4)));
__device__ __forceinline__ bf16x8 tr_frag(const unsigned char* base, int row0, int col0, int q15) {
    const int r1 = row0 + (q15 >> 2), r2 = r1 + 4, ch = (col0 >> 3) + ((q15 & 3) >> 1), sub = (q15 & 1) * 8;
    const s16x4s a = __builtin_amdgcn_ds_read_tr16_b64_v4i16((LAS s16x4s*)(base + r1 * 128 + ((ch ^ (r1 & 7)) << 4) + sub));
    const s16x4s b = __builtin_amdgcn_ds_read_tr16_b64_v4i16((LAS s16x4s*)(base + r2 * 128 + ((ch ^ (r2 & 7)) << 4) + sub));
    bf16x8 r; r[0] = a[0]; r[1] = a[1]; r[2] = a[2]; r[3] = a[3]; r[4] = b[0]; r[5] = b[1]; r[6] = b[2]; r[7] = b[3]; return r;
}
__device__ void phase_scan(const int tid, const int bid, const Params& P, int l, unsigned char* lds_raw) {
    unsigned char* WUT = lds_raw;
    unsigned char* AUT = lds_raw + 8192;
    float* s_v   = (float*)(lds_raw + 32768);
    float* s_t1  = (float*)(lds_raw + 40960);
    float* s_t2  = (float*)(lds_raw + 49152);
    float* s_y   = (float*)(lds_raw + 57344);
    float* s_rhs = (float*)(lds_raw + 65536);
    unsigned char* Xb  = lds_raw + 73728;
    unsigned char* Ybb = lds_raw + 81920;
    unsigned char* Vb  = lds_raw + 90112;
    unsigned char* UVT = lds_raw + 98304;
    unsigned char* S0b = lds_raw + 106496;
    unsigned char* AKf = lds_raw + 114688;
    unsigned char* RBK = lds_raw + 118784;
    float* Lf   = (float*)(lds_raw + 122880);
    float* s_gc = (float*)(lds_raw + 126976);
    float* s_bd = (float*)(lds_raw + 127232);
    float* s_wt = (float*)(lds_raw + 127488);
    const int lane = tid & 63, wid = __builtin_amdgcn_readfirstlane(tid >> 6), q15 = lane & 15, g4 = lane >> 4;
    const int tt = wid >> 1, j0 = (wid & 1) * 2; const bool isR = tt >= 2;
    const bf16_t* PR = P.big + 2 * U1; const bf16_t* PK = P.big + 8 * U1; const bf16_t* PV = P.big + 9 * U1; const bf16_t* LO = P.big + 3 * U1;
    for (int chain = bid; chain < 256; chain += gridDim.x) {
        const int d = chain >> 7, b = (chain >> 3) & 15, hd = chain & 7;
        __syncthreads();
        for (int i = tid; i < 4096; i += 512) {
            const int r = i >> 6, c = i & 63;
            *(bf16_t*)(WUT + sw_off(c, r)) = bf1(P.w_up[(((size_t)l * 2 + d) * 64 + r) * 512 + hd * 64 + c]);
            *(bf16_t*)(AUT + sw_off(c, r)) = bf1(P.a_up[(((size_t)l * 2 + d) * 64 + r) * 512 + hd * 64 + c]);
        }
        f32x4 St[2];
        St[0] = (f32x4){0.f, 0.f, 0.f, 0.f}; St[1] = St[0];
        const int tl = tid >> 4, c0 = (tid & 15) * 4;
        const int hc = hd * 64 + c0;
        const size_t pl = (size_t)l * 2 + d;
        u32x2 n_r2, n_k2, n_v2, n_rp2, n_kp2, n_vp2, n_w2, n_a2, n_wp2, n_ap2;
#define SCAN_LOAD_RAW(CHUNK) do { \
            const int tau_ = (CHUNK) * CH + tl; \
            const int s_ = d ? (SEQ - 1 - tau_) : tau_, sp_ = d ? s_ + 1 : s_ - 1; \
            const bool hasp_ = tau_ > 0; \
            const size_t row_ = (size_t)b * SEQ + s_, prow_ = (size_t)b * SEQ + (hasp_ ? sp_ : s_); \
            n_r2 = *(const u32x2*)(PR + row_ * 512 + hc); n_k2 = *(const u32x2*)(PK + row_ * 512 + hc); n_v2 = *(const u32x2*)(PV + row_ * 512 + hc); \
            n_rp2 = *(const u32x2*)(PR + prow_ * 512 + hc); n_kp2 = *(const u32x2*)(PK + prow_ * 512 + hc); n_vp2 = *(const u32x2*)(PV + prow_ * 512 + hc); \
            n_w2 = *(const u32x2*)(LO + row_ * 512 + d * 64 + c0); n_a2 = *(const u32x2*)(LO + row_ * 512 + 128 + d * 64 + c0); \
            n_wp2 = *(const u32x2*)(LO + prow_ * 512 + d * 64 + c0); n_ap2 = *(const u32x2*)(LO + prow_ * 512 + 128 + d * 64 + c0); \
            if (!hasp_) { n_rp2 = (u32x2){0u, 0u}; n_kp2 = n_rp2; n_vp2 = n_rp2; n_wp2 = n_rp2; n_ap2 = n_rp2; } } while (0)
        SCAN_LOAD_RAW(0);
        for (int chunk = 0; chunk < SEQ / CH; ++chunk) {
            int tidl = tid; asm volatile("" : "+v"(tidl));
            const int lane = tidl & 63, q15 = lane & 15, g4 = lane >> 4, tl = tidl >> 4, c0 = (tidl & 15) * 4, hc = hd * 64 + c0;
            const u32x2 r2 = n_r2, k2 = n_k2, v2 = n_v2, rp2 = n_rp2, kp2 = n_kp2, vp2 = n_vp2, w2 = n_w2, a2 = n_a2, wp2 = n_wp2, ap2 = n_ap2;
            const f32x4 mur = *(const f32x4*)(P.mu_rkv + (pl * 3 + 0) * 512 + hc), muk = *(const f32x4*)(P.mu_rkv + (pl * 3 + 1) * 512 + hc), muv = *(const f32x4*)(P.mu_rkv + (pl * 3 + 2) * 512 + hc);
            const f32x4 muw = *(const f32x4*)(P.mu_w + pl * 64 + c0), mua = *(const f32x4*)(P.mu_a + pl * 64 + c0);
            float rr[4], kk[4], vv[4], xw4[4], xa4_[4];
#pragma unroll
            for (int q = 0; q < 4; ++q) {
                const float rc = (q & 1) ? bfhi(r2[q >> 1]) : bflo(r2[q >> 1]), rpv = (q & 1) ? bfhi(rp2[q >> 1]) : bflo(rp2[q >> 1]);
                const float kc = (q & 1) ? bfhi(k2[q >> 1]) : bflo(k2[q >> 1]), kpv = (q & 1) ? bfhi(kp2[q >> 1]) : bflo(kp2[q >> 1]);
                const float vc = (q & 1) ? bfhi(v2[q >> 1]) : bflo(v2[q >> 1]), vpv = (q & 1) ? bfhi(vp2[q >> 1]) : bflo(vp2[q >> 1]);
                const float wc_ = (q & 1) ? bfhi(w2[q >> 1]) : bflo(w2[q >> 1]), wpv = (q & 1) ? bfhi(wp2[q >> 1]) : bflo(wp2[q >> 1]);
                const float ac = (q & 1) ? bfhi(a2[q >> 1]) : bflo(a2[q >> 1]), apv = (q & 1) ? bfhi(ap2[q >> 1]) : bflo(ap2[q >> 1]);
                rr[q] = rc + (rpv - rc) * mur[q]; kk[q] = kc + (kpv - kc) * muk[q]; vv[q] = vc + (vpv - vc) * muv[q];
                xw4[q] = tanhf_(wc_ + (wpv - wc_) * muw[q]);
                xa4_[q] = ac + (apv - ac) * mua[q];
                s_v[tl * 64 + c0 + q] = vv[q];
            }
            { u32x2 w; w.x = pk_bf16(xw4[0], xw4[1]); w.y = pk_bf16(xw4[2], xw4[3]); *(u32x2*)(Xb + sw_off(tl, c0)) = w;
              w.x = pk_bf16(xa4_[0], xa4_[1]); w.y = pk_bf16(xa4_[2], xa4_[3]); *(u32x2*)(Ybb + sw_off(tl, c0)) = w; }
            __syncthreads();
            {
                const int mat = wid >> 2, mt = (wid >> 1) & 1, ntb = (wid & 1) * 2;
                const unsigned char* Ai = mat ? Ybb : Xb; const unsigned char* Bi = mat ? AUT : WUT;
                const bf16x8 af0 = sw_frag(Ai, 16 * mt + q15, 0, g4), af1 = sw_frag(Ai, 16 * mt + q15, 1, g4);
                float* Cm = (mat ? s_t2 : s_t1) + (mt * 16 + 4 * g4) * 64 + ntb * 16 + q15;
#pragma unroll
                for (int i = 0; i < 2; ++i) {
                    f32x4 cv = __builtin_amdgcn_mfma_f32_16x16x32_bf16(af0, sw_frag(Bi, 16 * (ntb + i) + q15, 0, g4), (f32x4){0.f, 0.f, 0.f, 0.f}, 0, 0, 0);
                    cv = __builtin_amdgcn_mfma_f32_16x16x32_bf16(af1, sw_frag(Bi, 16 * (ntb + i) + q15, 1, g4), cv, 0, 0, 0);
#pragma unroll
                    for (int e = 0; e < 4; ++e) Cm[e * 64 + 16 * i] = cv[e];
                }
            }
            __syncthreads();
            float a_[4], b_[4], k2v[4], lw[4], pw[4];
            {
                const f32x4 wz = *(const f32x4*)(P.w0 + pl * 512 + hc) + *(const f32x4*)(s_t1 + tl * 64 + c0), az = *(const f32x4*)(P.a0 + pl * 512 + hc) + *(const f32x4*)(s_t2 + tl * 64 + c0);
                const f32x4 kkw = *(const f32x4*)(P.k_k + (size_t)l * 512 + hc), kaw = *(const f32x4*)(P.k_a + (size_t)l * 512 + hc), rkw = *(const f32x4*)(P.r_k + (size_t)l * 512 + hc);
                float kn[4], av[4], ssq = 0.f, bd = 0.f;
#pragma unroll
                for (int q = 0; q < 4; ++q) {
                    av[q] = sigmoidf_(az[q]);
                    kn[q] = kk[q] * kkw[q]; ssq += kn[q] * kn[q];
                    k2v[q] = kk[q] * (1.0f + (av[q] - 1.0f) * kaw[q]);
                    bd += rr[q] * k2v[q] * rkw[q];
                }
                red16x2(ssq, bd);
                const float inv = __builtin_amdgcn_rcpf(fmaxf(__builtin_amdgcn_sqrtf(ssq), 1e-12f));
#pragma unroll
                for (int q = 0; q < 4; ++q) {
                    const float kq_ = kn[q] * inv;
                    a_[q] = -kq_; b_[q] = kq_ * av[q];
                    lw[q] = -0.6065306597126334f * sigmoidf_(wz[q]);
                }
#pragma unroll
                for (int q = 0; q < 4; ++q) {
                    float x = lw[q];
                    float y = __shfl_up(x, 16); if (lane >= 16) x += y;
                    y = __shfl_up(x, 32); if (lane >= 32) x += y;
                    pw[q] = x;
                }
                if (lane >= 48) *(f32x4*)(s_wt + wid * 64 + c0) = (f32x4){pw[0], pw[1], pw[2], pw[3]};
                if ((tid & 15) == 0) s_bd[tl] = bd;
            }
            __syncthreads();
            {
                f32x4 g = (f32x4){pw[0], pw[1], pw[2], pw[3]};
                for (int w2 = 0; w2 < wid; ++w2) g += *(const f32x4*)(s_wt + w2 * 64 + c0);
                float xa4[4], xr4[4], yb4[4], yk4[4];
#pragma unroll
                for (int q = 0; q < 4; ++q) {
                    const float eg = __expf(g[q]), egx = __expf(g[q] - lw[q]), eng = __expf(-g[q]);
                    xa4[q] = a_[q] * egx; xr4[q] = rr[q] * eg; yb4[q] = b_[q] * eng; yk4[q] = k2v[q] * eng;
                    if (tl == 31) s_gc[c0 + q] = eg;
                }
                u32x2 w;
                w.x = pk_bf16(xa4[0], xa4[1]); w.y = pk_bf16(xa4[2], xa4[3]); *(u32x2*)(Xb + sw_off(tl, c0)) = w;
                w.x = pk_bf16(xr4[0], xr4[1]); w.y = pk_bf16(xr4[2], xr4[3]); *(u32x2*)(Xb + sw_off(32 + tl, c0)) = w;
                w.x = pk_bf16(yb4[0], yb4[1]); w.y = pk_bf16(yb4[2], yb4[3]); *(u32x2*)(Ybb + sw_off(tl, c0)) = w;
                w.x = pk_bf16(yk4[0], yk4[1]); w.y = pk_bf16(yk4[2], yk4[3]); *(u32x2*)(Ybb + sw_off(32 + tl, c0)) = w;
                w.x = pk_bf16(vv[0], vv[1]); w.y = pk_bf16(vv[2], vv[3]); *(u32x2*)(Vb + sw_off(tl, c0)) = w;
#pragma unroll
                for (int i = 0; i < 2; ++i) {
                    u32x2 ws; ws.x = pk_bf16(St[i][0], St[i][1]); ws.y = pk_bf16(St[i][2], St[i][3]);
                    *(u32x2*)(S0b + sw_off(16 * (j0 + i) + q15, 16 * tt + 4 * g4)) = ws;
                }
            }
            __syncthreads();
            { const int nc = chunk + 1 < SEQ / CH ? chunk + 1 : chunk; SCAN_LOAD_RAW(nc); }
            f32x4 XS[2];
            {
                const bf16x8 xf0 = sw_frag(Xb, 16 * tt + q15, 0, g4), xf1 = sw_frag(Xb, 16 * tt + q15, 1, g4);
                f32x4 G[2];
#pragma unroll
                for (int i = 0; i < 2; ++i) {
                    const int br = 16 * (j0 + i) + q15;
                    G[i] = __builtin_amdgcn_mfma_f32_16x16x32_bf16(xf0, sw_frag(Ybb, br, 0, g4), (f32x4){0.f, 0.f, 0.f, 0.f}, 0, 0, 0);
                    G[i] = __builtin_amdgcn_mfma_f32_16x16x32_bf16(xf1, sw_frag(Ybb, br, 1, g4), G[i], 0, 0, 0);
                    XS[i] = __builtin_amdgcn_mfma_f32_16x16x32_bf16(xf0, tr_frag(S0b, 8 * g4, 16 * (j0 + i), q15), (f32x4){0.f, 0.f, 0.f, 0.f}, 0, 0, 0);
                    XS[i] = __builtin_amdgcn_mfma_f32_16x16x32_bf16(xf1, tr_frag(S0b, 32 + 8 * g4, 16 * (j0 + i), q15), XS[i], 0, 0, 0);
                }
#pragma unroll
                for (int i = 0; i < 2; ++i) {
                    const int yr = 16 * (j0 + i) + q15, j = yr & 31; const bool isK = (j0 + i) >= 2;
#pragma unroll
                    for (int e = 0; e < 4; ++e) {
                        const int t = (16 * tt + 4 * g4 + e) & 31;
                        const bool keep = isR ? (j <= t) : (j < t);
                        const float val = keep ? G[i][e] : 0.f;
                        if (!isR) { if (!isK) Lf[t * 32 + j] = val; else *(bf16_t*)(AKf + sw_off(t, 32 + j)) = bf1(val); }
                        else *(bf16_t*)(RBK + sw_off(t, (isK ? 32 : 0) + j)) = bf1(val);
                    }
                }
            }
            __syncthreads();
            {
                const int trow = 16 * (tt & 1) + q15;
                const bf16x8 af = sw_frag(isR ? RBK : AKf, trow, 1, g4);
                const bf16x8 uf1 = tr_frag(Vb, 8 * g4, 16 * tt, q15);
#pragma unroll
                for (int i = 0; i < 2; ++i) {
                    XS[i] = __builtin_amdgcn_mfma_f32_16x16x32_bf16(af, tr_frag(Vb, 8 * g4, 16 * (j0 + i), q15), XS[i], 0, 0, 0);
                    St[i] = __builtin_amdgcn_mfma_f32_16x16x32_bf16(uf1, tr_frag(Ybb, 32 + 8 * g4, 16 * (j0 + i), q15), St[i], 0, 0, 0);
                }
                if (!isR) {
#pragma unroll
                    for (int i = 0; i < 2; ++i)
#pragma unroll
                        for (int e = 0; e < 4; ++e) s_rhs[(16 * tt + 4 * g4 + e) * 64 + 16 * (j0 + i) + q15] = XS[i][e];
                }
            }
            __syncthreads();
            {
                const int m8 = lane & 7, vs_ = 8 * wid + (lane >> 3);
                const float* Lr = Lf + 4 * m8; const float* Rr = s_rhs + vs_;
                float uo[4] = {0.f, 0.f, 0.f, 0.f};
                float rown[4];
#pragma unroll
                for (int q = 0; q < 4; ++q) rown[q] = Rr[(4 * m8 + q) * 64];
#pragma unroll
                for (int tg = 0; tg < 4; ++tg) {
                    f32x4 l4[8];
#pragma unroll
                    for (int r8 = 0; r8 < 8; ++r8) l4[r8] = *(const f32x4*)(Lr + (8 * tg + r8) * 32);
#pragma unroll
                    for (int hg = 0; hg < 2; ++hg) {
                        const int k = 2 * tg + hg;
                        float p[4];
#pragma unroll
                        for (int r = 0; r < 4; ++r) {
                            const f32x4 lv = l4[4 * hg + r];
                            p[r] = lv[0] * uo[0] + lv[1] * uo[1] + lv[2] * uo[2] + lv[3] * uo[3];
                        }
                        red8x4(p[0], p[1], p[2], p[3]);
                        const f32x4 l1 = l4[4 * hg + 1], l2 = l4[4 * hg + 2], l3 = l4[4 * hg + 3];
                        const float u0 = rown[0] + p[0];
                        const float u1 = rown[1] + p[1] + l1[0] * u0;
                        const float u2 = rown[2] + p[2] + l2[0] * u0 + l2[1] * u1;
                        const float u3 = rown[3] + p[3] + l3[0] * u0 + l3[1] * u1 + l3[2] * u2;
                        const bool own = (m8 == k);
                        uo[0] = own ? u0 : uo[0]; uo[1] = own ? u1 : uo[1]; uo[2] = own ? u2 : uo[2]; uo[3] = own ? u3 : uo[3];
                    }
                    __builtin_amdgcn_sched_barrier(0);
                }
                u32x2 w; w.x = pk_bf16(uo[0], uo[1]); w.y = pk_bf16(uo[2], uo[3]);
                *(u32x2*)(UVT + sw_off(vs_, 4 * m8)) = w;
            }
            __syncthreads();
            {
                const bf16x8 uf0 = sw_frag(UVT, 16 * tt + q15, 0, g4);
                if (isR) {
                    const bf16x8 af0 = sw_frag(RBK, 16 * (tt & 1) + q15, 0, g4);
#pragma unroll
                    for (int i = 0; i < 2; ++i) XS[i] = __builtin_amdgcn_mfma_f32_16x16x32_bf16(af0, sw_frag(UVT, 16 * (j0 + i) + q15, 0, g4), XS[i], 0, 0, 0);
#pragma unroll
                    for (int i = 0; i < 2; ++i)
#pragma unroll
                        for (int e = 0; e < 4; ++e) s_y[(16 * (tt & 1) + 4 * g4 + e) * 64 + 16 * (j0 + i) + q15] = XS[i][e];
                }
#pragma unroll
                for (int i = 0; i < 2; ++i) {
                    St[i] = __builtin_amdgcn_mfma_f32_16x16x32_bf16(uf0, tr_frag(Ybb, 8 * g4, 16 * (j0 + i), q15), St[i], 0, 0, 0);
                    St[i] = St[i] * s_gc[16 * (j0 + i) + q15];
                }
            }
            __syncthreads();
            {
                const int tau = chunk * CH + tl;
                const int s = d ? (SEQ - 1 - tau) : tau;
                const size_t row = (size_t)b * SEQ + s;
                const f32x4 y4 = *(const f32x4*)(s_y + tl * 64 + c0), v4 = *(const f32x4*)(s_v + tl * 64 + c0);
                float sm = y4[0] + y4[1] + y4[2] + y4[3];
                { float dummy_ = 0.f; red16x2(sm, dummy_); }
                const float mean = sm * (1.0f / 64.0f);
                float vs = 0.f;
#pragma unroll
                for (int q = 0; q < 4; ++q) { const float dd = y4[q] - mean; vs += dd * dd; }
                { float dummy_ = 0.f; red16x2(vs, dummy_); }
                const float rs = rsqrtf(vs * (1.0f / 64.0f) + 64e-5f);
                const f32x4 gw = *(const f32x4*)(P.gn_w + (size_t)l * 512 + hc), gb = *(const f32x4*)(P.gn_b + (size_t)l * 512 + hc);
                const float bd = s_bd[tl];
                float o4[4];
#pragma unroll
                for (int q = 0; q < 4; ++q) o4[q] = (y4[q] - mean) * rs * gw[q] + gb[q] + bd * v4[q];
                u32x2 w; w.x = pk_bf16(o4[0], o4[1]); w.y = pk_bf16(o4[2], o4[3]);
                *(u32x2*)(P.yd + (size_t)d * U1 + row * 512 + hc) = w;
                __syncthreads();
            }
        }
    }
}

__device__ __forceinline__ void load_row64(const bf16_t* p, float* o) {
#pragma unroll
    for (int c = 0; c < 8; ++c) {
        const u32x4 v = *(const u32x4*)(p + c * 8);
#pragma unroll
        for (int q = 0; q < 4; ++q) { o[c * 8 + 2 * q] = bflo(v[q]); o[c * 8 + 2 * q + 1] = bfhi(v[q]); }
    }
}
__device__ void phase_attn_simple(const int tid, const int bid, const Params& P, int l, const int lo, const int hi) {
    bf16_t* AQ = P.big; const bf16_t* AK = P.big + 4 * U1; const bf16_t* AV = P.big + 5 * U1;
    bf16_t* NQ = P.big + U1; const bf16_t* NK = P.big + 6 * U1; const bf16_t* NV = P.big + 7 * U1;
    for (int idx = lo * 262144 + bid * 512 + tid; idx < hi * 262144; idx += gridDim.x * 512) {
        const int which = idx >> 18, i2 = idx & 262143, tok = i2 >> 3, hd = i2 & 7, b = tok >> 11, s = tok & 2047;
        bf16_t* qp = (which ? NQ : AQ) + (size_t)tok * 512 + hd * 64;
        const bf16_t* Kb = (which ? NK : AK) + (size_t)b * SEQ * 512 + hd * 64;
        const bf16_t* Vb = (which ? NV : AV) + (size_t)b * SEQ * 512 + hd * 64;
        float q[64], acc[64];
        load_row64(qp, q);
#pragma unroll
        for (int i = 0; i < 64; ++i) { q[i] *= 0.125f; acc[i] = 0.f; }
        float mx = -1e30f, den = 0.f;
        const int nkeys = which ? 128 : 387;
        const int r = s >> 6, cc = s & 63;
        const int rs = min(max(r - 4, 0), 24), cs = min(max(cc - 8, 0), 48);
        for (int e = 0; e < nkeys; ++e) {
            int sk; float bias = 0.f;
            if (which) {
                const int i = e >> 4, j = e & 15, kr = rs + i, kc = cs + j;
                sk = kr * 64 + kc;
                bias = P.rpb[(((size_t)l * 8 + hd) * 15 + (kr - r + 7)) * 31 + (kc - cc + 15)];
            } else {
                const int g = e / 129, off = e - g * 129 - 64;
                sk = s + (off << (2 * g));
                if (sk < 0 || sk >= SEQ) continue;
            }
            const bf16_t* kp = Kb + (size_t)sk * 512;
            float sc = bias;
#pragma unroll
            for (int c = 0; c < 8; ++c) {
                const u32x4 v = *(const u32x4*)(kp + c * 8);
#pragma unroll
                for (int qd = 0; qd < 4; ++qd) { sc += q[c * 8 + 2 * qd] * bflo(v[qd]); sc += q[c * 8 + 2 * qd + 1] * bfhi(v[qd]); }
            }
            if (sc > mx) {
                const float corr = __expf(mx - sc);
                den *= corr;
#pragma unroll
                for (int i = 0; i < 64; ++i) acc[i] *= corr;
                mx = sc;
            }
            const float p = __expf(sc - mx);
            den += p;
            const bf16_t* vp = Vb + (size_t)sk * 512;
#pragma unroll
            for (int c = 0; c < 8; ++c) {
                const u32x4 v = *(const u32x4*)(vp + c * 8);
#pragma unroll
                for (int qd = 0; qd < 4; ++qd) { acc[c * 8 + 2 * qd] += p * bflo(v[qd]); acc[c * 8 + 2 * qd + 1] += p * bfhi(v[qd]); }
            }
        }
        const float inv = 1.0f / den;
#pragma unroll
        for (int c = 0; c < 8; ++c) {
            u32x4 w;
#pragma unroll
            for (int qd = 0; qd < 4; ++qd) w[qd] = pk_bf16(acc[c * 8 + 2 * qd] * inv, acc[c * 8 + 2 * qd + 1] * inv);
            *(u32x4*)(qp + c * 8) = w;
        }
    }
}


typedef short s16x4 __attribute__((ext_vector_type(4)));
__device__ __forceinline__ bf16x8 tr_pair(const unsigned char* p0, const unsigned char* p1) {
    const s16x4 a = __builtin_amdgcn_ds_read_tr16_b64_v4i16((LAS s16x4*)p0);
    const s16x4 b = __builtin_amdgcn_ds_read_tr16_b64_v4i16((LAS s16x4*)p1);
    bf16x8 r; r[0] = a[0]; r[1] = a[1]; r[2] = a[2]; r[3] = a[3]; r[4] = b[0]; r[5] = b[1]; r[6] = b[2]; r[7] = b[3]; return r;
}
__device__ void phase_attnA(const int tid, const int bid, const Params& P, unsigned char* lds) {
    const bf16_t* AQ = P.big; const bf16_t* AK = P.big + 4 * U1; const bf16_t* AV = P.big + 5 * U1;
    unsigned char* sK = lds; unsigned char* sV = lds + 272 * 128;
    const int lane = tid & 63, wid = __builtin_amdgcn_readfirstlane(tid >> 6), q15 = lane & 15, g = lane >> 4;
    u32x4 pkv[5], pvv[5]; bf16x8 pq[2];
#define ATTNA_FETCH(UNIT) do { \
        const int rnd_ = (UNIT) >> 8, wb_ = (UNIT) & 255, pat_ = rnd_ >> 3, idx_ = (rnd_ & 7) * 32 + (wb_ >> 3), b_ = idx_ >> 4, hd_ = wb_ & 7, sub_ = idx_ & 15; \
        const int shift_ = 2 * pat_, L_ = SEQ >> shift_; \
        const int j_ = pat_ == 0 ? 0 : (pat_ == 1 ? (sub_ >> 2) : sub_), i0_ = pat_ == 0 ? sub_ * 128 : (pat_ == 1 ? (sub_ & 3) * 128 : 0); \
        const size_t tb_ = (size_t)b_ * SEQ; \
        _Pragma("unroll") for (int it = 0; it < 5; ++it) { \
            const int c = tid + it * 512, r = c >> 3, ch = c & 7, i = i0_ - 64 + r; \
            pkv[it] = (u32x4){0u, 0u, 0u, 0u}; pvv[it] = pkv[it]; \
            if (c < 272 * 8 && i >= 0 && i < L_) { const size_t o = (tb_ + ((size_t)i << shift_) + j_) * 512 + hd_ * 64 + ch * 8; pkv[it] = *(const u32x4*)(AK + o); pvv[it] = *(const u32x4*)(AV + o); } } \
        const size_t qt_ = tb_ + ((size_t)(i0_ + 16 * wid + q15) << shift_) + j_; \
        pq[0] = *(const bf16x8*)(AQ + qt_ * 512 + hd_ * 64 + g * 8); pq[1] = *(const bf16x8*)(AQ + qt_ * 512 + hd_ * 64 + 32 + g * 8); } while (0)
    if (bid < 6144) ATTNA_FETCH(bid);
    for (int unit = bid; unit < 6144; unit += gridDim.x) {
        const int rnd = unit >> 8, wb = unit & 255, pat = rnd >> 3, idx = (rnd & 7) * 32 + (wb >> 3), b = idx >> 4, hd = wb & 7, sub = idx & 15;
        const int shift = 2 * pat, L = SEQ >> shift;
        const int j = pat == 0 ? 0 : (pat == 1 ? (sub >> 2) : sub), i0 = pat == 0 ? sub * 128 : (pat == 1 ? (sub & 3) * 128 : 0);
        const size_t tb = (size_t)b * SEQ;
        __syncthreads();
#pragma unroll
        for (int it = 0; it < 5; ++it) {
            const int c = tid + it * 512, r = c >> 3, ch = c & 7;
            const int off = r * 128 + ((ch ^ (r & 7)) << 4);
            if (c < 272 * 8) { *(u32x4*)(sK + off) = pkv[it]; *(u32x4*)(sV + off) = pvv[it]; }
        }
        const int qi = i0 + 16 * wid + q15;
        const size_t qtok = tb + ((size_t)qi << shift) + j;
        bf16x8 qf[2];
        qf[0] = pq[0]; qf[1] = pq[1];
        __syncthreads();
        if (unit + (int)gridDim.x < 6144) ATTNA_FETCH(unit + (int)gridDim.x);
        f32x4 sc[10];
#pragma unroll
        for (int kt = 0; kt < 9; ++kt) {
            sc[kt] = (f32x4){0.f, 0.f, 0.f, 0.f};
            const int row = 16 * (wid + kt) + q15;
#pragma unroll
            for (int ks = 0; ks < 2; ++ks) {
                const bf16x8 kf = *(const bf16x8*)(sK + row * 128 + (((ks * 4 + g) ^ (row & 7)) << 4));
                sc[kt] = __builtin_amdgcn_mfma_f32_16x16x32_bf16(kf, qf[ks], sc[kt], 0, 0, 0);
            }
        }
        float mx = -1e30f;
        const int gq = 4 * g - q15, kbase = qi - 64 + gq;
#pragma unroll
        for (int kt = 0; kt < 9; ++kt)
#pragma unroll
            for (int e = 0; e < 4; ++e) {
                const int ki = kbase + 16 * kt + e;
                bool valid = (unsigned)ki < (unsigned)L;
                if (kt == 0) valid = valid && (gq + e >= 0);
                if (kt == 8) valid = valid && (gq + e <= 0);
                const float s = valid ? sc[kt][e] * 0.125f : -1e30f;
                sc[kt][e] = s; mx = fmaxf(mx, s);
            }
        mx = fmaxf(mx, __shfl_xor(mx, 16)); mx = fmaxf(mx, __shfl_xor(mx, 32));
        float den = 0.f;
#pragma unroll
        for (int kt = 0; kt < 9; ++kt)
#pragma unroll
            for (int e = 0; e < 4; ++e) { const float p = __expf(sc[kt][e] - mx); sc[kt][e] = p; den += p; }
        sc[9] = (f32x4){0.f, 0.f, 0.f, 0.f};
        den += __shfl_xor(den, 16); den += __shfl_xor(den, 32);
        f32x4 o[4];
#pragma unroll
        for (int nt = 0; nt < 4; ++nt) o[nt] = (f32x4){0.f, 0.f, 0.f, 0.f};
#pragma unroll
        for (int t2 = 0; t2 < 5; ++t2) {
            union { bf16x8 v; unsigned u[4]; } pf;
            pf.u[0] = pk_bf16(sc[2 * t2][0], sc[2 * t2][1]); pf.u[1] = pk_bf16(sc[2 * t2][2], sc[2 * t2][3]);
            pf.u[2] = pk_bf16(sc[2 * t2 + 1][0], sc[2 * t2 + 1][1]); pf.u[3] = pk_bf16(sc[2 * t2 + 1][2], sc[2 * t2 + 1][3]);
            const int vrow = 16 * (wid + 2 * t2) + 4 * g + (q15 >> 2);
#pragma unroll
            for (int nt = 0; nt < 4; ++nt) {
                const unsigned char* a1 = sV + vrow * 128 + (((nt * 2 + ((q15 & 3) >> 1)) ^ (vrow & 7)) << 4) + (q15 & 1) * 8;
                const bf16x8 vf = tr_pair(a1, a1 + 16 * 128);
                o[nt] = __builtin_amdgcn_mfma_f32_16x16x32_bf16(vf, pf.v, o[nt], 0, 0, 0);
            }
        }
        const float inv = 1.0f / den;
        bf16_t* op = P.part + (size_t)pat * U1 + qtok * 512 + hd * 64 + 4 * g;
#pragma unroll
        for (int nt = 0; nt < 4; ++nt) { u32x2 w; w.x = pk_bf16(o[nt][0] * inv, o[nt][1] * inv); w.y = pk_bf16(o[nt][2] * inv, o[nt][3] * inv); *(u32x2*)(op + nt * 16) = w; }
        if (g == 0) P.lse[((size_t)pat * T_TOK + qtok) * 8 + hd] = mx + __logf(den);
    }
}

__device__ void phase_attnB(const int tid, const int bid, const Params& P, const int l, unsigned char* lds) {
    bf16_t* NQ = P.big + U1; const bf16_t* NK = P.big + 6 * U1; const bf16_t* NV = P.big + 7 * U1;
    unsigned char* sV = lds; float* s_tab = (float*)(lds + 65536); float* s_mg = (float*)(lds + 65536 + 2048);
    const int lane = tid & 63, wid = __builtin_amdgcn_readfirstlane(tid >> 6), q15 = lane & 15, g = lane >> 4, qt = wid & 3, kh = wid >> 2;
    for (int unit = bid; unit < 4096; unit += gridDim.x) {
        const int rnd = unit >> 8, wb = unit & 255, idx = rnd * 32 + (wb >> 3), b = idx >> 5, hd = wb & 7, r = idx & 31;
        const int rs = min(max(r - 4, 0), 24);
        const size_t tb = (size_t)b * SEQ;
        __syncthreads();
        {
            u32x4 vv[8];
#pragma unroll
            for (int it = 0; it < 8; ++it) { const int c = tid + it * 512, row = c >> 3, ch = c & 7; vv[it] = *(const u32x4*)(NV + (tb + rs * 64 + row) * 512 + hd * 64 + ch * 8); }
#pragma unroll
            for (int it = 0; it < 8; ++it) { const int c = tid + it * 512, row = c >> 3, ch = c & 7; *(u32x4*)(sV + row * 128 + ((ch ^ (row & 7)) << 4)) = vv[it]; }
        }
        if (tid < 465) s_tab[tid] = P.rpb[((size_t)l * 8 + hd) * 465 + tid];
        const int cq = 16 * qt + q15;
        const size_t qtok = tb + r * 64 + cq;
        bf16x8 qf[2];
        qf[0] = *(const bf16x8*)(NQ + qtok * 512 + hd * 64 + g * 8); qf[1] = *(const bf16x8*)(NQ + qtok * 512 + hd * 64 + 32 + g * 8);
        const int cb = min(max(16 * qt - 8, 0), 32);
        f32x4 sc[8];
#pragma unroll
        for (int ti = 0; ti < 8; ++ti) {
            const int krl = ti >> 1, ct = ti & 1;
            const size_t ktok = tb + (rs + 4 * kh + krl) * 64 + cb + 16 * ct + q15;
            sc[ti] = (f32x4){0.f, 0.f, 0.f, 0.f};
#pragma unroll
            for (int ks = 0; ks < 2; ++ks) {
                const bf16x8 kf = *(const bf16x8*)(NK + ktok * 512 + hd * 64 + ks * 32 + g * 8);
                sc[ti] = __builtin_amdgcn_mfma_f32_16x16x32_bf16(kf, qf[ks], sc[ti], 0, 0, 0);
            }
        }
        __syncthreads();
        const int cs = min(max(cq - 8, 0), 48);
        float mx = -1e30f;
#pragma unroll
        for (int ti = 0; ti < 8; ++ti)
#pragma unroll
            for (int e = 0; e < 4; ++e) {
                const int krl = ti >> 1, ct = ti & 1;
                const int kc = cb + 16 * ct + 4 * g + e;
                const bool valid = (kc >= cs) && (kc < cs + 16);
                const int bidx = (rs + 4 * kh + krl - r + 7) * 31 + (kc - cq + 15);
                const float bias = s_tab[valid ? bidx : 0];
                const float s = valid ? sc[ti][e] * 0.125f + bias : -1e30f;
                sc[ti][e] = s; mx = fmaxf(mx, s);
            }
        mx = fmaxf(mx, __shfl_xor(mx, 16)); mx = fmaxf(mx, __shfl_xor(mx, 32));
        float den = 0.f;
#pragma unroll
        for (int ti = 0; ti < 8; ++ti)
#pragma unroll
            for (int e = 0; e < 4; ++e) { const float p = __expf(sc[ti][e] - mx); sc[ti][e] = p; den += p; }
        den += __shfl_xor(den, 16); den += __shfl_xor(den, 32);
        f32x4 o[4];
#pragma unroll
        for (int nt = 0; nt < 4; ++nt) o[nt] = (f32x4){0.f, 0.f, 0.f, 0.f};
#pragma unroll
        for (int krl = 0; krl < 4; ++krl) {
            union { bf16x8 v; unsigned u[4]; } pf;
            pf.u[0] = pk_bf16(sc[2 * krl][0], sc[2 * krl][1]); pf.u[1] = pk_bf16(sc[2 * krl][2], sc[2 * krl][3]);
            pf.u[2] = pk_bf16(sc[2 * krl + 1][0], sc[2 * krl + 1][1]); pf.u[3] = pk_bf16(sc[2 * krl + 1][2], sc[2 * krl + 1][3]);
            const int vrow = (4 * kh + krl) * 64 + cb + 4 * g + (q15 >> 2);
#pragma unroll
            for (int nt = 0; nt < 4; ++nt) {
                const unsigned char* a1 = sV + vrow * 128 + (((nt * 2 + ((q15 & 3) >> 1)) ^ (vrow & 7)) << 4) + (q15 & 1) * 8;
                const bf16x8 vf = tr_pair(a1, a1 + 16 * 128);
                o[nt] = __builtin_amdgcn_mfma_f32_16x16x32_bf16(vf, pf.v, o[nt], 0, 0, 0);
            }
        }
        float* mg = s_mg + (qt * 64 + lane) * 18;
        if (kh == 1) {
            mg[0] = mx; mg[1] = den;
#pragma unroll
            for (int nt = 0; nt < 4; ++nt)
#pragma unroll
                for (int e = 0; e < 4; ++e) mg[2 + nt * 4 + e] = o[nt][e];
        }
        __syncthreads();
        if (kh == 0) {
            const float m2 = mg[0], d2 = mg[1];
            const float M = fmaxf(mx, m2), a1 = __expf(mx - M), a2 = __expf(m2 - M);
            const float inv = 1.0f / (den * a1 + d2 * a2);
            bf16_t* op = NQ + qtok * 512 + hd * 64 + 4 * g;
#pragma unroll
            for (int nt = 0; nt < 4; ++nt) {
                float v[4];
#pragma unroll
                for (int e = 0; e < 4; ++e) v[e] = (o[nt][e] * a1 + mg[2 + nt * 4 + e] * a2) * inv;
                u32x2 w; w.x = pk_bf16(v[0], v[1]); w.y = pk_bf16(v[2], v[3]);
                *(u32x2*)(op + nt * 16) = w;
            }
        }
    }
}

__device__ void phase_attnA_merge(const int tid, const int bid, const Params& P) {
    for (int idx0 = bid * 512 + tid; idx0 < T_TOK * 64; idx0 += gridDim.x * 512 * 4) {
        u32x4 v0[4], v1[4], v2[4]; float l0[4], l1[4], l2[4];
#pragma unroll
        for (int k = 0; k < 4; ++k) {
            const int idxr = idx0 + k * gridDim.x * 512, idx = idxr < T_TOK * 64 ? idxr : idx0, tok = idx >> 6, hd = (idx >> 3) & 7, ch = idx & 7;
            const size_t o = (size_t)tok * 512 + hd * 64 + ch * 8;
            l0[k] = P.lse[((size_t)0 * T_TOK + tok) * 8 + hd]; l1[k] = P.lse[((size_t)1 * T_TOK + tok) * 8 + hd]; l2[k] = P.lse[((size_t)2 * T_TOK + tok) * 8 + hd];
            v0[k] = *(const u32x4*)(P.part + o); v1[k] = *(const u32x4*)(P.part + U1 + o); v2[k] = *(const u32x4*)(P.part + 2 * U1 + o);
        }
#pragma unroll
        for (int k = 0; k < 4; ++k) {
            const int idxr = idx0 + k * gridDim.x * 512, idx = idxr < T_TOK * 64 ? idxr : idx0, tok = idx >> 6, hd = (idx >> 3) & 7, ch = idx & 7;
            const size_t o = (size_t)tok * 512 + hd * 64 + ch * 8;
            const float m = fmaxf(l0[k], fmaxf(l1[k], l2[k]));
            float a0 = __expf(l0[k] - m), a1 = __expf(l1[k] - m), a2 = __expf(l2[k] - m);
            const float inv = __builtin_amdgcn_rcpf(a0 + a1 + a2); a0 *= inv; a1 *= inv; a2 *= inv;
            u32x4 w;
#pragma unroll
            for (int q = 0; q < 4; ++q) w[q] = pk_bf16(a0 * bflo(v0[k][q]) + a1 * bflo(v1[k][q]) + a2 * bflo(v2[k][q]), a0 * bfhi(v0[k][q]) + a1 * bfhi(v1[k][q]) + a2 * bfhi(v2[k][q]));
            *(u32x4*)(P.big + o) = w;
        }
    }
}

constexpr int NPHASE = 1 + DEPTH * 12 + 1;
__device__ __forceinline__ void run_phase(const Params& P, int ph, unsigned char* lds) {
    int tid = threadIdx.x; asm volatile("" : "+v"(tid));
    int bid = blockIdx.x; asm volatile("" : "+s"(bid));
    if (ph == 0) { phase_mod(tid, bid, P, lds); convert_layer(tid, bid, P, 0, P.wb0, lds); return; }
    if (ph == NPHASE - 1) { phase_final_norm(tid, bid, P.out, P.final_norm); return; }
    const int l = (ph - 1) / 12, sp = (ph - 1) % 12;
    const bf16_t* wb = (l & 1) ? P.wb1 : P.wb0;
    const float* mod = P.mod + (size_t)l * 16 * NMOD;
    const float* xin = (l == 0) ? P.x : P.out;
    switch (sp) {
    case 0: phase_norm(tid, bid, xin, P.norm_g + ((size_t)l * 3 + 0) * DM, mod + 0 * DM, mod + 1 * DM, P.h); break;
    case 1: { EpiSwiglu E; E.O = P.big; run_gemm(tid, bid, lds, P.h, DM, 0, wb + W_WI1, DM, 0, T_TOK, 2 * DFF, DM, 1, E); } break;
    case 2: { EpiResid E; E.xs = xin; E.xd = P.out; E.gate = mod + 2 * DM; E.scale = 0.5f; run_gemm(tid, bid, lds, P.big, DFF, 0, wb + W_WO1, DFF, 0, T_TOK, DM, DFF, 1, E); } break;
    case 3: phase_norm(tid, bid, P.out, P.norm_g + ((size_t)l * 3 + 1) * DM, mod + 3 * DM, mod + 4 * DM, P.h);
            if (l + 1 < DEPTH) convert_layer(tid, bid, P, l + 1, ((l + 1) & 1) ? P.wb1 : P.wb0, lds);
            break;
    case 4: { EpiProj E; E.big = P.big; E.rope = P.rope; run_gemm(tid, bid, lds, P.h, DM, 0, wb + W_MIX, DM, 0, T_TOK, 5120, DM, 1, E); } break;
    case 5: phase_scan(tid, bid, P, l, lds); phase_attnA(tid, bid, P, lds); phase_attnB(tid, bid, P, l, lds); break;
    case 6: phase_attnA_merge(tid, bid, P);
            { EpiOc E; E.O = P.big + 2 * U1; E.yd = P.yd; run_gemm(tid, bid, lds, P.big + 3 * U1 + 256, 512, 0, wb + W_GUP, 256, 0, T_TOK, 512, 256, 1, E); }
            { EpiGates E; E.G0 = P.big + 4 * U1; run_gemm(tid, bid, lds, P.h, DM, 0, wb + W_G, DM, 0, T_TOK, 3072, DM, 1, E); }
            break;
    case 7: { EpiBranch E; E.Mg = P.h; E.G0 = P.big + 4 * U1; run_gemm(tid, bid, lds, P.big, 512, U1 * 2, wb + W_BR, 512, (size_t)1024 * 512 * 2, T_TOK, DM, 512, 3, E); } break;
    case 8: { EpiResid E; E.xs = P.out; E.xd = P.out; E.gate = mod + 5 * DM; E.scale = 1.0f; run_gemm(tid, bid, lds, P.h, DM, 0, wb + W_OUT, DM, 0, T_TOK, DM, DM, 1, E); } break;
    case 9: phase_norm(tid, bid, P.out, P.norm_g + ((size_t)l * 3 + 2) * DM, mod + 6 * DM, mod + 7 * DM, P.h); break;
    case 10: { EpiSwiglu E; E.O = P.big; run_gemm(tid, bid, lds, P.h, DM, 0, wb + W_WI2, DM, 0, T_TOK, 2 * DFF, DM, 1, E); } break;
    case 11: { EpiResid E; E.xs = P.out; E.xd = P.out; E.gate = mod + 8 * DM; E.scale = 0.5f; run_gemm(tid, bid, lds, P.big, DFF, 0, wb + W_WO2, DFF, 0, T_TOK, DM, DFF, 1, E); } break;
    }
}

extern __shared__ __attribute__((aligned(16))) unsigned char dyn_lds[];

#define XB_TMO      128
#define XB_XCNT(j)  (256  + 64 * (j))
#define XB_XSUB(j)  (1280 + 64 * (j))
#define XB_XGEN(j)  (2304 + 64 * (j))
#define XB_TOP      3328
#define XB_TOPGEN   3392
#define XCD_BAR_WORDS 3456
#define XB_SPIN_CAP (1u << 18)
__device__ __forceinline__ unsigned xb_ld(unsigned* p)              { return __hip_atomic_load(p, __ATOMIC_RELAXED, __HIP_MEMORY_SCOPE_AGENT); }
__device__ __forceinline__ unsigned xb_add(unsigned* p, unsigned v) { return __hip_atomic_fetch_add(p, v, __ATOMIC_RELAXED, __HIP_MEMORY_SCOPE_AGENT); }
__device__ __forceinline__ unsigned xb_xcc_id() { return (unsigned)__builtin_amdgcn_s_getreg((3 << 11) | 20) & 0xFu; }
#define XB_SPIN(cond, bar) do { unsigned _sp = 0; while (cond) { __builtin_amdgcn_s_sleep(1); \
    if ((++_sp & 255u) == 0u) { if (xb_ld(&(bar)[XB_TMO])) break; if (_sp > XB_SPIN_CAP) { atomicAdd(&(bar)[XB_TMO], 1u); break; } } } } while (0)
struct XcdBarrier { unsigned* bar; unsigned x; volatile LAS unsigned* st; };
__device__ __forceinline__ XcdBarrier xcd_barrier_post(unsigned* bar, volatile LAS unsigned* st) {
    XcdBarrier b; b.bar = bar; b.x = xb_xcc_id(); b.st = st;
    if (threadIdx.x == 0) (void)xb_add(&bar[XB_XCNT(b.x)], 1u);
    return b;
}
__device__ __forceinline__ void xcd_barrier_complete(unsigned* bar, unsigned x, unsigned& nloc, unsigned& nx) {
    const unsigned G = gridDim.x * gridDim.y * gridDim.z;
    unsigned sum, cnt, mine, sp = 0u;
    for (;;) {
        sum = 0u; cnt = 0u; mine = 0u;
#pragma unroll
        for (unsigned j = 0; j < 16; ++j) { const unsigned c = xb_ld(&bar[XB_XCNT(j)]); sum += c; cnt += (c > 0u) ? 1u : 0u; mine = (j == x) ? c : mine; }
        if (sum == G) break;
        __builtin_amdgcn_s_sleep(1);
        if ((++sp & 255u) == 0u) { if (xb_ld(&bar[XB_TMO])) break; if (sp > XB_SPIN_CAP) { atomicAdd(&bar[XB_TMO], 1u); break; } }
    }
    nloc = mine > 0u ? mine : 1u; nx = cnt > 0u ? cnt : 1u;
}
__device__ __forceinline__ void xcd_barrier(const XcdBarrier& b) {
    asm volatile("s_waitcnt vmcnt(0)" ::: "memory");
    __syncthreads();
    if (threadIdx.x == 0) {
        unsigned* bar = b.bar;
        __builtin_amdgcn_s_waitcnt(0);
        unsigned nloc = b.st[0], nx = b.st[1];
        if (nloc == 0u) { xcd_barrier_complete(bar, b.x, nloc, nx); b.st[0] = nloc; b.st[1] = nx; }
        const unsigned old = xb_add(&bar[XB_XSUB(b.x)], 1u);
        const unsigned gen = old / nloc;
        if (old + 1u == (gen + 1u) * nloc) {
            __builtin_amdgcn_fence(__ATOMIC_RELEASE, "agent");
            asm volatile("s_waitcnt vmcnt(0)" ::: "memory");
            const unsigned og = xb_add(&bar[XB_TOP], 1u);
            const unsigned tg = og / nx;
            if (og + 1u == (tg + 1u) * nx) xb_add(&bar[XB_TOPGEN], 1u);
            else XB_SPIN(xb_ld(&bar[XB_TOPGEN]) == tg, bar);
            __builtin_amdgcn_fence(__ATOMIC_ACQUIRE, "agent");
            xb_add(&bar[XB_XGEN(b.x)], 1u);
            asm volatile("s_waitcnt vmcnt(0)" ::: "memory");
        } else {
            XB_SPIN(xb_ld(&bar[XB_XGEN(b.x)]) == gen, bar);
            __builtin_amdgcn_fence(__ATOMIC_ACQUIRE, "agent");
            asm volatile("s_waitcnt vmcnt(0)" ::: "memory");
        }
    }
    __syncthreads();
}
__global__ void __launch_bounds__(512, 2) mega_kernel(Params P) {
    cg::grid_group grid = cg::this_grid();
    volatile LAS unsigned* st = (volatile LAS unsigned*)(LAS unsigned char*)(dyn_lds + LDS_BYTES - 16);
    if (threadIdx.x == 0) { st[0] = 0u; st[1] = 0u; }
    __syncthreads();
    const XcdBarrier xb = xcd_barrier_post(P.bar, st);
    for (int ph = 0; ph < NPHASE; ++ph) {
        run_phase(P, ph, dyn_lds);
        if (ph == 0) grid.sync();
        else if (ph + 1 < NPHASE) xcd_barrier(xb);
    }
}
#if MK_LAUNCHES != 1
__global__ void __launch_bounds__(512, 2) phase_kernel(Params P, int ph) { run_phase(P, ph, dyn_lds); }
#endif

extern "C" void kernel_launch(void* const* d_in, const int* in_sizes, int n_in, void* d_out, int out_size, void* d_ws, size_t ws_size, hipStream_t stream) {
    Params P{};
    P.x = (const float*)d_in[0]; P.c = (const float*)d_in[1]; P.pos = (const int*)d_in[2];
    P.ada_w = (const float*)d_in[3]; P.ada_b = (const float*)d_in[4]; P.norm_g = (const float*)d_in[5]; P.ffn_wi = (const float*)d_in[6]; P.ffn_wo = (const float*)d_in[7];
    P.w_in = (const float*)d_in[8]; P.rpb = (const float*)d_in[9]; P.mu_rkv = (const float*)d_in[10]; P.mu_w = (const float*)d_in[11]; P.mu_a = (const float*)d_in[12];
    P.w0 = (const float*)d_in[13]; P.w_up = (const float*)d_in[14]; P.a0 = (const float*)d_in[15]; P.a_up = (const float*)d_in[16]; P.g_up = (const float*)d_in[17];
    P.k_k = (const float*)d_in[18]; P.k_a = (const float*)d_in[19]; P.r_k = (const float*)d_in[20]; P.gn_w = (const float*)d_in[21]; P.gn_b = (const float*)d_in[22];
    P.w_branch = (const float*)d_in[23]; P.w_out = (const float*)d_in[24]; P.final_norm = (const float*)d_in[25];
    P.out = (float*)d_out;
    unsigned char* w = (unsigned char*)d_ws; size_t off = 0;
    auto take = [&](size_t bytes) { void* p = w + off; off += (bytes + 255) & ~(size_t)255; return p; };
    P.mod = (float*)take((size_t)4 * 16 * NMOD * 4);
    P.rope = (float*)take((size_t)T_TOK * 16 * 4);
    P.wb0 = (bf16_t*)take(W_TOTAL * 2);
    P.wb1 = (bf16_t*)take(W_TOTAL * 2);
    P.h = (bf16_t*)take((size_t)T_TOK * 1024 * 2);
    P.big = (bf16_t*)take(10 * U1 * 2);
    P.yd = (bf16_t*)take(2 * U1 * 2);
    P.part = (bf16_t*)take(3 * U1 * 2);
    P.lse = (float*)take((size_t)3 * T_TOK * 8 * 4);
    P.bar = (unsigned*)take(XCD_BAR_WORDS * 4);
    if (off > ws_size) { fprintf(stderr, "workspace too small: need %zu have %zu\n", off, ws_size); return; }
#if MK_LAUNCHES == 1
    static int grid_blocks = 0;
    if (!grid_blocks) {
        int dev = 0, cus = 0, per_cu = 0;
        hipGetDevice(&dev);
        hipDeviceGetAttribute(&cus, hipDeviceAttributeMultiprocessorCount, dev);
        hipFuncSetAttribute((const void*)mega_kernel, hipFuncAttributeMaxDynamicSharedMemorySize, LDS_BYTES);
        hipOccupancyMaxActiveBlocksPerMultiprocessor(&per_cu, mega_kernel, 512, LDS_BYTES);
        if (per_cu < 1) per_cu = 1;
        grid_blocks = cus * per_cu;
    }
    (void)hipMemsetAsync(P.bar, 0, XCD_BAR_WORDS * 4, stream);
    void* args[] = {&P};
    hipError_t e = hipLaunchCooperativeKernel((void*)mega_kernel, dim3(grid_blocks), dim3(512), args, LDS_BYTES, stream);
    if (e != hipSuccess) fprintf(stderr, "cooperative launch failed: %s (grid %d)\n", hipGetErrorString(e), grid_blocks);
#else
    static int inited = 0;
    if (!inited) { hipFuncSetAttribute((const void*)phase_kernel, hipFuncAttributeMaxDynamicSharedMemorySize, LDS_BYTES); inited = 1; }
    for (int ph = 0; ph < NPHASE; ++ph) phase_kernel<<<256, 512, LDS_BYTES, stream>>>(P, ph);
#endif
}
```
